# Optimizing an MI355X kernel written in HIP

```python
import math
import jax, jax.numpy as jnp
from jax import lax
import numpy as np


D_MODEL = 2048
BATCH = 4
SEQ = 4096
DEPTH = 2

GRID_W = 64
CTX_LEN = 256
NORM_EPS = 1e-6
N_BRANCH = 4
BRANCH_WIDTH = D_MODEL // 2

SSD_HEADDIM = 64
SSD_D_INNER = BRANCH_WIDTH
SSD_HEADS = SSD_D_INNER // SSD_HEADDIM
SSD_GROUPS = 4
SSD_STATE = 128
SSD_CONV_DIM = SSD_D_INNER + 2 * SSD_GROUPS * SSD_STATE
SSD_CONV_K = 5
SSD_CHUNK = 128

NA_HEAD_DIM = 64
NA_HEADS = BRANCH_WIDTH // NA_HEAD_DIM
NA_WIN_R = 8
NA_WIN_C = 16

GLA_HEADS = 4
GLA_V_DIM = BRANCH_WIDTH
GLA_K_DIM = BRANCH_WIDTH // 2
GLA_HEAD_K = GLA_K_DIM // GLA_HEADS
GLA_HEAD_V = GLA_V_DIM // GLA_HEADS
GLA_GATE_RANK = 16
GLA_TAU = 16.0
GLA_CHUNK = 64

SWA_HEAD_DIM = 64
SWA_HEADS = BRANCH_WIDTH // SWA_HEAD_DIM
SWA_KV_HEADS = 4
SWA_WINDOW = 128
SWA_BLOCK = 128
ROPE_BASE = 10000.0
ROPE_AXIS_DIM = SWA_HEAD_DIM // 2

PEER_HEADS = 8
PEER_NKEYS = 128
PEER_EXPERTS = PEER_NKEYS * PEER_NKEYS
PEER_QDIM = 256
PEER_TOPK = 16
PEER_BLOCK = 128

IN_SPLITS = (SSD_D_INNER, SSD_CONV_DIM, 2 * SSD_HEADS,
             3 * BRANCH_WIDTH,
             GLA_K_DIM, GLA_K_DIM, GLA_V_DIM, GLA_V_DIM, 2 * GLA_GATE_RANK,
             SWA_HEADS * SWA_HEAD_DIM, SWA_KV_HEADS * SWA_HEAD_DIM, SWA_KV_HEADS * SWA_HEAD_DIM,
             N_BRANCH * D_MODEL)
IN_WIDTH = sum(IN_SPLITS)

F32 = jnp.float32

kernel_name = 'hybrid_ssd_na_gla_swa_peer_block'


def rms_norm(x, g):
    xf = x.astype(F32)
    y = xf * lax.rsqrt(jnp.mean(xf * xf, axis=-1, keepdims=True) + NORM_EPS)
    return (y * g.astype(F32)).astype(x.dtype)


def modulate(h, shift, scale):
    return h * (1 + scale) + shift


def split_cols(p):
    idx = np.cumsum(np.array(IN_SPLITS))[:-1].tolist()
    return jnp.split(p, idx, axis=-1)


def flip(t):
    return jnp.flip(t, axis=1)


def dwconv_centered(x, w, b):
    k = w.shape[0]
    y = lax.conv_general_dilated(x, w[:, None, :].astype(x.dtype), window_strides=(1,),
                                 padding=[(k // 2, k // 2)],
                                 dimension_numbers=('NWC', 'WIO', 'NWC'),
                                 feature_group_count=x.shape[-1])
    return y + b.astype(x.dtype)


def axial_rope_tables(s):
    t = jnp.arange(s)
    row = (t // GRID_W).astype(F32)
    col = (t % GRID_W).astype(F32)
    nf = ROPE_AXIS_DIM // 2
    inv = ROPE_BASE ** (-jnp.arange(nf, dtype=F32) / nf)
    ar = row[:, None] * inv
    ac = col[:, None] * inv
    return (jnp.cos(ar), jnp.sin(ar), jnp.cos(ac), jnp.sin(ac))


def apply_axial_rope(x, tabs):
    cr, sr, cc, sc = tabs
    xf = x.astype(F32)

    def rot(xa, cos, sin):
        x1, x2 = jnp.split(xa, 2, axis=-1)
        cos = cos[:, None, :]
        sin = sin[:, None, :]
        return jnp.concatenate([x1 * cos - x2 * sin, x1 * sin + x2 * cos], axis=-1)

    return jnp.concatenate([rot(xf[..., :ROPE_AXIS_DIM], cr, sr),
                            rot(xf[..., ROPE_AXIS_DIM:], cc, sc)], axis=-1).astype(x.dtype)


def ctx_attend(q, k, v, sink):
    bsz, n, hq, dh = q.shape
    hk = k.shape[2]
    grp = hq // hk
    qg = q.reshape(bsz, n, hk, grp, dh)
    logits = jnp.einsum('bqhgd,bkhd->bhgqk', qg, k).astype(F32) * dh ** -0.5
    if sink is not None:
        s_sink = jnp.broadcast_to(sink.astype(F32).reshape(hk, grp, 1, 1), logits.shape[:-1] + (1,))
        logits = jnp.concatenate([logits, s_sink], axis=-1)
    p = jax.nn.softmax(logits, axis=-1).astype(v.dtype)
    o = jnp.einsum('bhgqk,bkhd->bqhgd', p[..., :k.shape[1]], v)
    return o.reshape(bsz, n, hq * dh)


def segsum(a):
    n = a.shape[-1]
    cs = jnp.cumsum(a, axis=-1)
    diff = cs[..., :, None] - cs[..., None, :]
    mask = jnp.tril(jnp.ones((n, n), dtype=bool))
    return jnp.where(mask, diff, -jnp.inf)


def ssd_scan(xs, dt, a, bm, cm, h0):
    bsz, s, h, p = xs.shape
    n = bm.shape[-1]
    L = SSD_CHUNK
    nc = s // L
    xdt = (xs * dt[..., None]).reshape(bsz, nc, L, h, p)
    ad = (dt * a).reshape(bsz, nc, L, h).transpose(0, 3, 1, 2)
    bc = bm.reshape(bsz, nc, L, h, n)
    cc = cm.reshape(bsz, nc, L, h, n)
    a_cs = jnp.cumsum(ad, axis=-1)
    cb = jnp.einsum('bclhn,bcshn->bhcls', cc, bc) * jnp.exp(segsum(ad))
    y_diag = jnp.einsum('bhcls,bcshp->bclhp', cb, xdt)
    decay_states = jnp.exp(a_cs[..., -1:] - a_cs)
    states = jnp.einsum('bclhn,bhcl,bclhp->bchpn', bc, decay_states, xdt)
    if h0 is None:
        h0 = jnp.zeros_like(states[:, 0])
    states = jnp.concatenate([h0[:, None].astype(states.dtype), states], axis=1)
    decay_chunk = jnp.exp(segsum(jnp.pad(a_cs[..., -1], ((0, 0), (0, 0), (1, 0)))))
    new_states = jnp.einsum('bhzc,bchpn->bzhpn', decay_chunk, states)
    y_off = jnp.einsum('bclhn,bchpn,bhcl->bclhp', cc, new_states[:, :-1], jnp.exp(a_cs))
    return (y_diag + y_off).reshape(bsz, s, h, p), new_states[:, -1]


def ssd_bidir(xs, bm, cm, dt, a, h0f, h0b):
    yf, hf = ssd_scan(xs, dt[:, :, 0], a[0], bm, cm, h0f)
    yb, hb = ssd_scan(flip(xs), flip(dt[:, :, 1]), a[1], flip(bm), flip(cm), h0b)
    return yf + flip(yb), hf, hb


def ssd_branch(px, pc, conv_w, conv_b, a_log, dt_bias, d_skip, norm_g, need_ctx):
    a = -jnp.exp(a_log.astype(F32))

    def prep(xbc, dt_raw):
        bsz, s, _ = xbc.shape
        xbc = jax.nn.silu(dwconv_centered(xbc, conv_w, conv_b))
        xs, bm, cm = jnp.split(xbc, [SSD_D_INNER, SSD_D_INNER + SSD_GROUPS * SSD_STATE], axis=-1)
        rep = SSD_HEADS // SSD_GROUPS
        xs = xs.reshape(bsz, s, SSD_HEADS, SSD_HEADDIM)
        bm = jnp.repeat(bm.reshape(bsz, s, SSD_GROUPS, SSD_STATE), rep, axis=2)
        cm = jnp.repeat(cm.reshape(bsz, s, SSD_GROUPS, SSD_STATE), rep, axis=2)
        dt = jax.nn.softplus(dt_raw.reshape(bsz, s, 2, SSD_HEADS).astype(F32) + dt_bias.astype(F32))
        return xs, bm, cm, dt

    def finish(y, xs, z):
        bsz, s, _ = z.shape
        y = (y + d_skip.astype(F32)[:, None] * xs.astype(F32)).reshape(bsz, s, SSD_D_INNER).astype(z.dtype)
        return rms_norm(y * jax.nn.silu(z), norm_g)

    z, xbc, dt_raw = px
    zc, xbcc, dtc_raw = pc
    cx, cbm, ccm, cdt = prep(xbcc, dtc_raw)
    yc, hcf, hcb = ssd_bidir(cx, cbm, ccm, cdt, a, None, None)
    xs, bm, cm, dt = prep(xbc, dt_raw)
    y, _, _ = ssd_bidir(xs, bm, cm, dt, a, hcf, hcb)
    out_c = finish(yc, cx, zc) if need_ctx else None
    return finish(y, xs, z), out_c


def na_attend(q, k, v, kc, vc, rpb):
    bsz, s, h, dh = q.shape
    rows = s // GRID_W
    wr = min(NA_WIN_R, rows)
    n_nb = wr * NA_WIN_C
    scale = dh ** -0.5
    qg = q.reshape(bsz, rows, GRID_W, h, dh)
    kg = k.reshape(bsz, rows, GRID_W, h, dh)
    vg = v.reshape(bsz, rows, GRID_W, h, dh)
    cols = jnp.arange(GRID_W)
    c_start = jnp.clip(cols - NA_WIN_C // 2, 0, GRID_W - NA_WIN_C)
    col_idx = c_start[:, None] + jnp.arange(NA_WIN_C)[None, :]
    col_rel = col_idx - cols[:, None] + (NA_WIN_C - 1)

    def row_block(r):
        r0 = jnp.clip(r - wr // 2, 0, rows - wr)
        q_r = lax.dynamic_index_in_dim(qg, r, axis=1, keepdims=False)
        k_nb = lax.dynamic_slice_in_dim(kg, r0, wr, axis=1)[:, :, col_idx]
        v_nb = lax.dynamic_slice_in_dim(vg, r0, wr, axis=1)[:, :, col_idx]
        row_rel = r0 + jnp.arange(wr) - r + (NA_WIN_R - 1)
        bias = rpb[:, row_rel[:, None, None], col_rel[None, :, :]]
        bias = bias.transpose(0, 2, 1, 3).astype(F32)
        s_nb = jnp.einsum('bqhd,brqjhd->bhqrj', q_r, k_nb).astype(F32) * scale + bias
        s_cx = jnp.einsum('bqhd,bchd->bhqc', q_r, kc).astype(F32) * scale
        logits = jnp.concatenate([s_nb.reshape(bsz, h, GRID_W, n_nb), s_cx], axis=-1)
        p = jax.nn.softmax(logits, axis=-1).astype(v.dtype)
        p_nb = p[..., :n_nb].reshape(bsz, h, GRID_W, wr, NA_WIN_C)
        return (jnp.einsum('bhqrj,brqjhd->bqhd', p_nb, v_nb)
                + jnp.einsum('bhqc,bchd->bqhd', p[..., n_nb:], vc))

    o = lax.map(row_block, jnp.arange(rows))
    return o.transpose(1, 0, 2, 3, 4).reshape(bsz, s, h * dh)


def na_branch(pqkv, pqkvc, q_norm, k_norm, rpb, need_ctx):
    def heads(t):
        bsz, s, _ = t.shape
        t = t.reshape(bsz, s, 3, NA_HEADS, NA_HEAD_DIM)
        return rms_norm(t[:, :, 0], q_norm), rms_norm(t[:, :, 1], k_norm), t[:, :, 2]

    q, k, v = heads(pqkv)
    qc, kc, vc = heads(pqkvc)
    out = na_attend(q, k, v, kc, vc, rpb)
    out_c = ctx_attend(qc, kc, vc, None) if need_ctx else None
    return out, out_c


def gla_chunk_scan(q, k, v, g, s0):
    bsz, s, h, dk = q.shape
    dv = v.shape[-1]
    L = GLA_CHUNK
    nc = s // L
    q = q.reshape(bsz, nc, L, h, dk)
    k = k.reshape(bsz, nc, L, h, dk)
    v = v.reshape(bsz, nc, L, h, dv)
    gc = jnp.cumsum(g.reshape(bsz, nc, L, h, dk), axis=2)
    q_in = q * jnp.exp(gc)
    k_in = k * jnp.exp(-gc)
    k_out = k * jnp.exp(gc[:, :, -1:] - gc)
    att = jnp.einsum('bclhk,bcshk->bchls', q_in, k_in)
    att = jnp.where(jnp.tril(jnp.ones((L, L), dtype=bool)), att, 0.0)
    o_intra = jnp.einsum('bchls,bcshv->bclhv', att, v)
    s_chunk = jnp.einsum('bclhk,bclhv->bchkv', k_out, v)
    decay = jnp.exp(gc[:, :, -1])
    if s0 is None:
        s0 = jnp.zeros_like(s_chunk[:, 0])

    def step(state, inp):
        dec, sc = inp
        return state * dec[..., None] + sc, state

    s_final, s_before = lax.scan(step, s0.astype(s_chunk.dtype),
                                 (decay.transpose(1, 0, 2, 3), s_chunk.transpose(1, 0, 2, 3, 4)))
    o_inter = jnp.einsum('bclhk,cbhkv->bclhv', q_in, s_before)
    return (o_intra + o_inter).reshape(bsz, s, h, dv), s_final


def gla_bidir(q, k, v, g, s0f, s0b):
    of, sf = gla_chunk_scan(q, k, v, g[:, :, 0], s0f)
    ob, sb = gla_chunk_scan(flip(q), flip(k), flip(v), flip(g[:, :, 1]), s0b)
    return of + flip(ob), sf, sb


def gla_branch(px, pc, w_gate, b_gate, norm_g, need_ctx):
    def prep(q, k, v, glr):
        bsz, s, _ = q.shape
        q = q.reshape(bsz, s, GLA_HEADS, GLA_HEAD_K) * (GLA_HEAD_K ** -0.5)
        k = k.reshape(bsz, s, GLA_HEADS, GLA_HEAD_K)
        v = v.reshape(bsz, s, GLA_HEADS, GLA_HEAD_V)
        logit = jnp.einsum('bsdr,dre->bsde', glr.reshape(bsz, s, 2, GLA_GATE_RANK), w_gate) + b_gate
        g = (jax.nn.log_sigmoid(logit.astype(F32)) / GLA_TAU).reshape(bsz, s, 2, GLA_HEADS, GLA_HEAD_K)
        return q, k, v, g

    def finish(o, r):
        bsz, s, _ = r.shape
        o = rms_norm(o.astype(r.dtype), norm_g).reshape(bsz, s, GLA_V_DIM)
        return o * jax.nn.silu(r)

    q, k, v, r, glr = px
    qc, kc, vc, rc, glrc = pc
    cq, ck, cv, cg = prep(qc, kc, vc, glrc)
    oc, scf, scb = gla_bidir(cq, ck, cv, cg, None, None)
    lq, lk, lv, lg = prep(q, k, v, glr)
    o, _, _ = gla_bidir(lq, lk, lv, lg, scf, scb)
    out_c = finish(oc, rc) if need_ctx else None
    return finish(o, r), out_c


def swa_attend(q, k, v, kc, vc, sink):
    bsz, s, hq, dh = q.shape
    hk = k.shape[2]
    grp = hq // hk
    blk = SWA_BLOCK
    nb = s // blk
    scale = dh ** -0.5
    qb = q.reshape(bsz, nb, blk, hk, grp, dh)

    def band(t):
        tp = jnp.pad(t, ((0, 0), (blk, blk), (0, 0), (0, 0))).reshape(bsz, nb + 2, blk, hk, dh)
        return jnp.concatenate([tp[:, :-2], tp[:, 1:-1], tp[:, 2:]], axis=2)

    kb = band(k)
    vb = band(v)
    qpos = jnp.arange(s).reshape(nb, blk)
    kpos = jnp.arange(-blk, s + blk).reshape(nb + 2, blk)
    kpos = jnp.concatenate([kpos[:-2], kpos[1:-1], kpos[2:]], axis=1)
    valid = ((jnp.abs(qpos[:, :, None] - kpos[:, None, :]) <= SWA_WINDOW)
             & (kpos >= 0)[:, None, :] & (kpos < s)[:, None, :])
    s_loc = jnp.einsum('bnqhgd,bnkhd->bhgnqk', qb, kb).astype(F32) * scale
    s_loc = jnp.where(valid, s_loc, -jnp.inf)
    s_ctx = jnp.einsum('bnqhgd,bchd->bhgnqc', qb, kc).astype(F32) * scale
    s_sink = jnp.broadcast_to(sink.astype(F32).reshape(hk, grp, 1, 1, 1), s_loc.shape[:-1] + (1,))
    p = jax.nn.softmax(jnp.concatenate([s_loc, s_ctx, s_sink], axis=-1), axis=-1).astype(v.dtype)
    nk = 3 * blk
    nc = kc.shape[1]
    o = (jnp.einsum('bhgnqk,bnkhd->bnqhgd', p[..., :nk], vb)
         + jnp.einsum('bhgnqc,bchd->bnqhgd', p[..., nk:nk + nc], vc))
    return o.reshape(bsz, s, hq * dh)


def swa_branch(px, pc, q_norm, k_norm, sink, rope, need_ctx):
    def heads(q, k, v):
        bsz, s, _ = q.shape
        q = rms_norm(q.reshape(bsz, s, SWA_HEADS, SWA_HEAD_DIM), q_norm)
        k = rms_norm(k.reshape(bsz, s, SWA_KV_HEADS, SWA_HEAD_DIM), k_norm)
        return q, k, v.reshape(bsz, s, SWA_KV_HEADS, SWA_HEAD_DIM)

    q, k, v = heads(*px)
    qc, kc, vc = heads(*pc)
    q = apply_axial_rope(q, rope)
    k = apply_axial_rope(k, rope)
    out = swa_attend(q, k, v, kc, vc, sink)
    out_c = ctx_attend(qc, kc, vc, sink) if need_ctx else None
    return out, out_c


def merge_branches(gate_logits, outs, w_branch, w_out):
    g = jax.nn.sigmoid(gate_logits.reshape(gate_logits.shape[:-1] + (N_BRANCH, D_MODEL)))
    m = g[..., 0, :] * (outs[0] @ w_branch[0])
    for i in range(1, N_BRANCH):
        m = m + g[..., i, :] * (outs[i] @ w_branch[i])
    return m @ w_out


def mixer_sublayer(hx, hc, w_in, ssd_conv_w, ssd_conv_b, ssd_a_log, ssd_dt_bias, ssd_d, ssd_norm_g,
                   na_q_norm, na_k_norm, na_rpb, gla_w_gate, gla_b_gate, gla_norm_g,
                   swa_q_norm, swa_k_norm, swa_sink, w_branch, w_out, rope, need_ctx):
    px = split_cols(hx @ w_in)
    pc = split_cols(hc @ w_in)
    a_x, a_c = ssd_branch(px[0:3], pc[0:3], ssd_conv_w, ssd_conv_b, ssd_a_log, ssd_dt_bias, ssd_d,
                          ssd_norm_g, need_ctx)
    b_x, b_c = na_branch(px[3], pc[3], na_q_norm, na_k_norm, na_rpb, need_ctx)
    c_x, c_c = gla_branch(px[4:9], pc[4:9], gla_w_gate, gla_b_gate, gla_norm_g, need_ctx)
    d_x, d_c = swa_branch(px[9:12], pc[9:12], swa_q_norm, swa_k_norm, swa_sink, rope, need_ctx)
    out_x = merge_branches(px[12], (a_x, b_x, c_x, d_x), w_branch, w_out)
    out_c = merge_branches(pc[12], (a_c, b_c, c_c, d_c), w_branch, w_out) if need_ctx else None
    return out_x, out_c


def peer_ffn(h, wq, k1, k2, u_tab, v_tab):
    bsz, n, dm = h.shape
    t = h.reshape(bsz * n, dm)
    nt = t.shape[0]
    q = (t @ wq).reshape(nt, PEER_HEADS, 2, PEER_QDIM // 2)
    s1 = jnp.einsum('thd,kd->thk', q[:, :, 0], k1).astype(F32)
    s2 = jnp.einsum('thd,kd->thk', q[:, :, 1], k2).astype(F32)
    v1, i1 = lax.top_k(s1, PEER_TOPK)
    v2, i2 = lax.top_k(s2, PEER_TOPK)
    n_cand = PEER_TOPK * PEER_TOPK
    cand = (v1[..., :, None] + v2[..., None, :]).reshape(nt, PEER_HEADS, n_cand)
    cand_idx = (i1[..., :, None] * PEER_NKEYS + i2[..., None, :]).reshape(nt, PEER_HEADS, n_cand)
    top_s, pos = lax.top_k(cand, PEER_TOPK)
    idx = jnp.take_along_axis(cand_idx, pos, axis=-1)
    gate = jax.nn.softmax(top_s, axis=-1).astype(h.dtype)
    nsel = PEER_HEADS * PEER_TOPK
    nblk = nt // PEER_BLOCK

    def block(args):
        tb, ib, gb = args
        act = jax.nn.gelu(jnp.einsum('td,tkd->tk', tb, u_tab[ib]), approximate=False) * gb
        return jnp.einsum('tk,tkd->td', act, v_tab[ib])

    out = lax.map(block, (t.reshape(nblk, PEER_BLOCK, dm), idx.reshape(nblk, PEER_BLOCK, nsel),
                          gate.reshape(nblk, PEER_BLOCK, nsel)))
    return out.reshape(bsz, n, dm)


def setup_inputs(seed: int = 0) -> dict:
    key = jax.random.key(seed)
    ks = jax.random.split(key, 40)
    L = DEPTH
    D = D_MODEL

    def nrm(k, shape, std):
        return jax.random.normal(k, shape, F32) * std

    dt0 = jnp.exp(jax.random.uniform(ks[12], (L, 2, SSD_HEADS), F32, math.log(1e-3), math.log(1e-1)))
    return {
        'x': nrm(ks[0], (BATCH, SEQ, D), 1.0),
        'c': nrm(ks[1], (BATCH, D), 1.0),
        'ctx': nrm(ks[2], (BATCH, CTX_LEN, D), 1.0),
        'c_ctx': nrm(ks[3], (D,), 1.0),
        'w_ada': nrm(ks[4], (L, D, 6 * D), 0.5 * D ** -0.5),
        'b_ada': nrm(ks[5], (L, 6 * D), 0.02),
        'g_norm1': 1.0 + nrm(ks[6], (L, D), 0.02),
        'g_norm2': 1.0 + nrm(ks[7], (L, D), 0.02),
        'w_in': nrm(ks[8], (L, D, IN_WIDTH), D ** -0.5),
        'ssd_conv_w': nrm(ks[9], (L, SSD_CONV_K, SSD_CONV_DIM), SSD_CONV_K ** -0.5),
        'ssd_conv_b': nrm(ks[10], (L, SSD_CONV_DIM), 0.02),
        'ssd_a_log': jnp.log(jax.random.uniform(ks[11], (L, 2, SSD_HEADS), F32, 1.0, 16.0)),
        'ssd_dt_bias': dt0 + jnp.log(-jnp.expm1(-dt0)),
        'ssd_d': 1.0 + nrm(ks[13], (L, SSD_HEADS), 0.1),
        'ssd_norm_g': 1.0 + nrm(ks[14], (L, SSD_D_INNER), 0.02),
        'na_q_norm': 1.0 + nrm(ks[15], (L, NA_HEAD_DIM), 0.02),
        'na_k_norm': 1.0 + nrm(ks[16], (L, NA_HEAD_DIM), 0.02),
        'na_rpb': nrm(ks[17], (L, NA_HEADS, 2 * NA_WIN_R - 1, 2 * NA_WIN_C - 1), 0.1),
        'gla_w_gate': nrm(ks[18], (L, 2, GLA_GATE_RANK, GLA_K_DIM), GLA_GATE_RANK ** -0.5),
        'gla_b_gate': nrm(ks[19], (L, 2, GLA_K_DIM), 0.1),
        'gla_norm_g': 1.0 + nrm(ks[20], (L, GLA_HEAD_V), 0.02),
        'swa_q_norm': 1.0 + nrm(ks[21], (L, SWA_HEAD_DIM), 0.02),
        'swa_k_norm': 1.0 + nrm(ks[22], (L, SWA_HEAD_DIM), 0.02),
        'swa_sink': nrm(ks[23], (L, SWA_HEADS), 0.5),
        'w_branch': nrm(ks[24], (L, N_BRANCH, BRANCH_WIDTH, D), BRANCH_WIDTH ** -0.5),
        'w_out': nrm(ks[25], (L, D, D), D ** -0.5),
        'peer_wq': nrm(ks[26], (L, D, PEER_HEADS * PEER_QDIM), D ** -0.5),
        'peer_k1': nrm(ks[27], (L, PEER_NKEYS, PEER_QDIM // 2), (PEER_QDIM // 2) ** -0.5),
        'peer_k2': nrm(ks[28], (L, PEER_NKEYS, PEER_QDIM // 2), (PEER_QDIM // 2) ** -0.5),
        'peer_u': nrm(ks[29], (L, PEER_EXPERTS, D), D ** -0.5),
        'peer_v': nrm(ks[30], (L, PEER_EXPERTS, D), 0.5),
    }


def reference(x, c, ctx, c_ctx, w_ada, b_ada, g_norm1, g_norm2, w_in, ssd_conv_w, ssd_conv_b,
              ssd_a_log, ssd_dt_bias, ssd_d, ssd_norm_g, na_q_norm, na_k_norm, na_rpb,
              gla_w_gate, gla_b_gate, gla_norm_g, swa_q_norm, swa_k_norm, swa_sink,
              w_branch, w_out, peer_wq, peer_k1, peer_k2, peer_u, peer_v):
    rope = axial_rope_tables(x.shape[1])
    for l in range(DEPTH):
        need_ctx = l < DEPTH - 1
        mod_x = (jax.nn.silu(c) @ w_ada[l] + b_ada[l])[:, None, :]
        mod_c = (jax.nn.silu(c_ctx) @ w_ada[l] + b_ada[l])[None, None, :]
        sh1, sc1, gt1, sh2, sc2, gt2 = jnp.split(mod_x, 6, axis=-1)
        csh1, csc1, cgt1, csh2, csc2, cgt2 = jnp.split(mod_c, 6, axis=-1)
        hx = modulate(rms_norm(x, g_norm1[l]), sh1, sc1)
        hc = modulate(rms_norm(ctx, g_norm1[l]), csh1, csc1)
        mx, mc = mixer_sublayer(hx, hc, w_in[l], ssd_conv_w[l], ssd_conv_b[l], ssd_a_log[l],
                                ssd_dt_bias[l], ssd_d[l], ssd_norm_g[l], na_q_norm[l], na_k_norm[l],
                                na_rpb[l], gla_w_gate[l], gla_b_gate[l], gla_norm_g[l],
                                swa_q_norm[l], swa_k_norm[l], swa_sink[l], w_branch[l], w_out[l],
                                rope, need_ctx)
        x = x + gt1 * mx
        hx2 = modulate(rms_norm(x, g_norm2[l]), sh2, sc2)
        x = x + gt2 * peer_ffn(hx2, peer_wq[l], peer_k1[l], peer_k2[l], peer_u[l], peer_v[l])
        if need_ctx:
            ctx = ctx + cgt1 * mc
            hc2 = modulate(rms_norm(ctx, g_norm2[l]), csh2, csc2)
            ctx = ctx + cgt2 * peer_ffn(hc2, peer_wq[l], peer_k1[l], peer_k2[l], peer_u[l], peer_v[l])
    return x
```

```cpp
#include <hip/hip_runtime.h>
#include <cstdio>
#include <cstdint>
#include <type_traits>

#define LAS __attribute__((address_space(3)))
typedef unsigned short bf16_t;
typedef short bf16x8 __attribute__((ext_vector_type(8)));
typedef float f32x4 __attribute__((ext_vector_type(4)));
typedef float f32x2 __attribute__((ext_vector_type(2)));
typedef unsigned u32x4 __attribute__((ext_vector_type(4)));
typedef unsigned u32x2 __attribute__((ext_vector_type(2)));
typedef __bf16 bf2_t __attribute__((ext_vector_type(2)));
typedef __bf16 bf8_t __attribute__((ext_vector_type(8)));

constexpr int DM = 2048, NB = 4, SEQ = 4096, LCTX = 256, DEPTH = 2;
constexpr int RX = NB * SEQ;
constexpr int RC = NB * LCTX;
constexpr int MR = RX + RC;
constexpr int INW = 19008;
constexpr int INP = 19200;
constexpr int P1W = 10752;
constexpr int GW = 8192;
constexpr int C_Z = 0, C_XBC = 1024, C_NA = 3072, C_GQ = 6144, C_GK = 6656, C_GV = 7168, C_GR = 8192, C_SQ = 9216, C_SK = 10240, C_SV = 10496;
constexpr float EPS = 1e-6f;
constexpr int NEXP = 16384;

constexpr size_t al256(size_t x) { return (x + 255) & ~(size_t)255; }
constexpr size_t WS_CTL = 0;                                  constexpr size_t CTL_BYTES = 1u << 20;
constexpr size_t WS_MOD = WS_CTL + CTL_BYTES;                 constexpr size_t MOD_BYTES = al256((size_t)DEPTH * 5 * 6 * DM * 4);
constexpr size_t WS_WIN = WS_MOD + MOD_BYTES;                 constexpr size_t WIN_BYTES = (size_t)INP * DM * 2;
constexpr size_t WS_WBR = WS_WIN + WIN_BYTES;                 constexpr size_t WBR_BYTES = (size_t)4 * DM * 1024 * 2;
constexpr size_t WS_WOUT = WS_WBR + WBR_BYTES;                constexpr size_t WOUT_BYTES = (size_t)DM * DM * 2;
constexpr size_t WS_WQ = WS_WOUT + WOUT_BYTES;                constexpr size_t WQ_BYTES = (size_t)DM * DM * 2;
constexpr size_t WS_HN = WS_WQ + WQ_BYTES;                    constexpr size_t HN_BYTES = (size_t)MR * DM * 2;
constexpr size_t WS_P1 = WS_HN + HN_BYTES;                    constexpr size_t P1_BYTES = (size_t)MR * P1W * 2;
constexpr size_t WS_G = WS_P1 + P1_BYTES;                     constexpr size_t G_BYTES = (size_t)MR * GW * 2;
constexpr size_t WS_DTR = WS_G + G_BYTES;                     constexpr size_t DTR_BYTES = (size_t)MR * 32 * 4;
constexpr size_t WS_GLR = WS_DTR + DTR_BYTES;                 constexpr size_t GLR_BYTES = (size_t)MR * 32 * 4;
constexpr size_t WS_DT = WS_GLR + GLR_BYTES;                  constexpr size_t DT_BYTES = (size_t)MR * 32 * 4;
constexpr size_t WS_YS = WS_DT + DT_BYTES;                    constexpr size_t YS_BYTES = (size_t)2 * MR * 1024 * 2;
constexpr size_t WS_OG = WS_YS + YS_BYTES;                    constexpr size_t OG_BYTES = (size_t)2 * MR * 1024 * 2;
constexpr size_t WS_OUTS = WS_OG + OG_BYTES;                  constexpr size_t OUTS_BYTES = (size_t)4 * MR * 1024 * 2;
constexpr size_t WS_CTXS = WS_OUTS + OUTS_BYTES;              constexpr size_t CTXS_BYTES = (size_t)RC * DM * 4;
constexpr size_t WS_IDX = WS_CTXS + CTXS_BYTES;               constexpr size_t IDX_BYTES = (size_t)MR * 128 * 4;
constexpr size_t WS_GATE = WS_IDX + IDX_BYTES;                constexpr size_t GATE_BYTES = (size_t)MR * 128 * 4;
constexpr int VTS = SEQ + LCTX;
constexpr size_t WS_VTNA = WS_GATE + GATE_BYTES;              constexpr size_t VTNA_BYTES = (size_t)NB * 16 * 64 * VTS * 2;
constexpr size_t WS_VTSW = WS_VTNA + VTNA_BYTES;              constexpr size_t VTSW_BYTES = (size_t)NB * 4 * 64 * VTS * 2;
constexpr size_t WS_GCUM = WS_VTSW + VTSW_BYTES;              constexpr size_t GCUM_BYTES = (size_t)2 * MR * 512 * 4;
constexpr size_t WS_CSUM = WS_GCUM + GCUM_BYTES;              constexpr size_t CSUM_BYTES = (size_t)2 * MR * 16 * 4;
constexpr size_t WS_END = WS_CSUM + CSUM_BYTES;
constexpr size_t WS_MP = WS_P1;
constexpr size_t WS_MB = WS_MP + (size_t)MR * DM * 4;
constexpr size_t WS_QP = WS_MB + (size_t)MR * DM * 2;
static_assert(WS_QP + (size_t)MR * DM * 4 <= WS_P1 + P1_BYTES, "overlay");

constexpr size_t PE_U8 = 0, PE_V8 = (size_t)NEXP * DM, PE_SU = 2 * (size_t)NEXP * DM, PE_SV = PE_SU + (size_t)NEXP * 4;
constexpr size_t PE_HQ = PE_SV + (size_t)NEXP * 4;
constexpr size_t PE_HS = PE_HQ + (size_t)MR * DM;
static_assert(PE_HS + (size_t)MR * 16 * 4 <= G_BYTES, "PEER overlay");
constexpr int CW_BAR = 0;
constexpr int CW_Q = 4096;

__device__ __forceinline__ float bf2f(bf16_t v) { return __uint_as_float(((unsigned)v) << 16); }
__device__ __forceinline__ bf16_t f2bf(float f) { unsigned u = __float_as_uint(f); u += 0x7FFFu + ((u >> 16) & 1u); return (bf16_t)(u >> 16); }
__device__ __forceinline__ unsigned pack2(float lo, float hi) { return (unsigned)f2bf(lo) | ((unsigned)f2bf(hi) << 16); }
__device__ __forceinline__ float lo2f(unsigned w) { return __uint_as_float(w << 16); }
__device__ __forceinline__ float hi2f(unsigned w) { return __uint_as_float(w & 0xffff0000u); }
template <int M> __device__ __forceinline__ int xswi(int v) {
    if constexpr (M < 32) return __builtin_amdgcn_ds_swizzle(v, (M << 10) | 0x1f);
    else { const auto r = __builtin_amdgcn_permlane32_swap((unsigned)v, (unsigned)v, false, false); return (int)(r[0] ^ r[1] ^ (unsigned)v); }
}
template <int M> __device__ __forceinline__ float xsw(float v) { return __int_as_float(xswi<M>(__float_as_int(v))); }
__device__ __forceinline__ float wsum(float v) { v += xsw<32>(v); v += xsw<16>(v); v += xsw<8>(v); v += xsw<4>(v); v += xsw<2>(v); v += xsw<1>(v); return v; }
__device__ __forceinline__ float wmax(float v) { v = fmaxf(v, xsw<32>(v)); v = fmaxf(v, xsw<16>(v)); v = fmaxf(v, xsw<8>(v)); v = fmaxf(v, xsw<4>(v)); v = fmaxf(v, xsw<2>(v)); v = fmaxf(v, xsw<1>(v)); return v; }
__device__ __forceinline__ float rlane(float v, int l) { return __int_as_float(__builtin_amdgcn_readlane(__float_as_int(v), l)); }
__device__ __forceinline__ float siluf(float x) { return x / (1.f + __expf(-x)); }
__device__ __forceinline__ float sigmf(float x) { return 1.f / (1.f + __expf(-x)); }
#define MK_MULTI 0
#define XB_TMO      128
#define XB_XCNT(j)  (256  + 64 * (j))
#define XB_XSUB(j)  (1280 + 64 * (j))
#define XB_XGEN(j)  (2304 + 64 * (j))
#define XB_TOP      3328
#define XB_TOPGEN   3392
#define XCD_BAR_WORDS 3456
#define XB_SPIN_CAP (1u << 18)

__device__ __forceinline__ unsigned xb_ld(unsigned* p)              { return __hip_atomic_load(p, __ATOMIC_RELAXED, __HIP_MEMORY_SCOPE_AGENT); }
__device__ __forceinline__ unsigned xb_add(unsigned* p, unsigned v) { return __hip_atomic_fetch_add(p, v, __ATOMIC_RELAXED, __HIP_MEMORY_SCOPE_AGENT); }
__device__ __forceinline__ unsigned xb_xcc_id() { return (unsigned)__builtin_amdgcn_s_getreg((3 << 11) | 20) & 0xFu; }
#define XB_SPIN(cond, bar) do { unsigned _sp = 0; while (cond) { __builtin_amdgcn_s_sleep(1); \
    if ((++_sp & 255u) == 0u) { if (xb_ld(&(bar)[XB_TMO])) break; if (_sp > XB_SPIN_CAP) { atomicAdd(&(bar)[XB_TMO], 1u); break; } } } } while (0)

struct XcdBarrier {
    unsigned* bar; unsigned x;
    volatile LAS unsigned* st;
};

__device__ __forceinline__ XcdBarrier xcd_barrier_post(unsigned* bar, volatile LAS unsigned* st, int tid) {
    XcdBarrier b; b.bar = bar; b.x = xb_xcc_id(); b.st = st;
    if (tid == 0) (void)xb_add(&bar[XB_XCNT(b.x)], 1u);
    return b;
}
__device__ __forceinline__ void xcd_barrier_complete(unsigned* bar, unsigned x, unsigned& nloc, unsigned& nx) {
    const unsigned G = gridDim.x * gridDim.y * gridDim.z;
    unsigned sum, cnt, mine, sp = 0u;
    for (;;) {
        sum = 0u; cnt = 0u; mine = 0u;
#pragma unroll
        for (unsigned j = 0; j < 16; ++j) { const unsigned c = xb_ld(&bar[XB_XCNT(j)]); sum += c; cnt += (c > 0u) ? 1u : 0u; mine = (j == x) ? c : mine; }
        if (sum == G) break;
        __builtin_amdgcn_s_sleep(1);
        if ((++sp & 255u) == 0u) { if (xb_ld(&bar[XB_TMO])) break; if (sp > XB_SPIN_CAP) { atomicAdd(&bar[XB_TMO], 1u); break; } }
    }
    nloc = mine > 0u ? mine : 1u; nx = cnt > 0u ? cnt : 1u;
}

template <bool FIRST>
__device__ __forceinline__ void xcd_barrier_t(const XcdBarrier& b, int tid) {
    asm volatile("s_waitcnt vmcnt(0)" ::: "memory");
    __syncthreads();
    if (tid == 0) {
        unsigned* bar = b.bar;
        __builtin_amdgcn_s_waitcnt(0);
        unsigned nloc = b.st[0], nx = b.st[1];
        if constexpr (FIRST) { if (nloc == 0u) { xcd_barrier_complete(bar, b.x, nloc, nx); b.st[0] = nloc; b.st[1] = nx; } }
        const unsigned old = xb_add(&bar[XB_XSUB(b.x)], 1u);
        const unsigned gen = old / nloc;
        if (old + 1u == (gen + 1u) * nloc) {
            __builtin_amdgcn_fence(__ATOMIC_RELEASE, "agent");
            asm volatile("s_waitcnt vmcnt(0)" ::: "memory");
            const unsigned og = xb_add(&bar[XB_TOP], 1u);
            const unsigned tg = og / nx;
            if (og + 1u == (tg + 1u) * nx) xb_add(&bar[XB_TOPGEN], 1u);
            else XB_SPIN(xb_ld(&bar[XB_TOPGEN]) == tg, bar);
            __builtin_amdgcn_fence(__ATOMIC_ACQUIRE, "agent");
            xb_add(&bar[XB_XGEN(b.x)], 1u);
            asm volatile("s_waitcnt vmcnt(0)" ::: "memory");
        } else {
            XB_SPIN(xb_ld(&bar[XB_XGEN(b.x)]) == gen, bar);
            __builtin_amdgcn_fence(__ATOMIC_ACQUIRE, "agent");
            asm volatile("s_waitcnt vmcnt(0)" ::: "memory");
        }
    }
    __syncthreads();
}

#define PG8_LAS LAS
namespace pg8 {
constexpr int BM = 256, BK = 64, HALF = 128, HTB = HALF * BK * 2  , STAGE_BYTES = 8 * HTB, NXCD = 8, WGM = 4;

__host__ __device__ __forceinline__ int lds_byte(int r, int c) { const int st = (r >> 4) * 2 + (c >> 5), rr = r & 15, cc = c & 31, ob = rr * 64 + cc * 2; return st * 1024 + (ob ^ (((ob >> 9) & 1) << 5)); }
__host__ __device__ __forceinline__ void stage_rc(int b, int& R, int& C) { const int st = b / 1024, sb = b % 1024, swz = sb ^ (((sb >> 9) & 1) << 5); R = (st >> 1) * 16 + swz / 64; C = (st & 1) * 32 + (swz % 64) / 2; }
__host__ __device__ __forceinline__ int perm32(int rho) { const int n = rho >> 4, i = rho & 15; return 8 * (i >> 2) + 4 * n + (i & 3); }

struct Unit { int pm, pn; };
struct Gemm { const bf16_t* A; const bf16_t* Bt; int M, N, K; };

struct StaticOrder {
    int nM, nN, nwg, G, c;
    __host__ __device__ void init(int M, int N, int G_, int c_) { nM = M / BM; nN = N / BM; nwg = nM * nN; G = G_; c = c_; }
    __host__ __device__ bool next(int i, Unit& u) const {
        const long L = (long)i * G + c; if (L >= nwg) return false;
        int wgid = (int)L; { const int q = nwg / NXCD, r = nwg % NXCD, xcd = wgid % NXCD, off = wgid / NXCD; wgid = (xcd < r ? xcd * (q + 1) : r * (q + 1) + (xcd - r) * q) + off; }
        const int nig = WGM * nN, gid = wgid / nig, fm = gid * WGM, gsz = (nM - fm) < WGM ? (nM - fm) : WGM;
        u.pm = fm + ((wgid % nig) % gsz); u.pn = (wgid % nig) / gsz; return true;
    }
    __device__ __forceinline__ void a_ready(const Unit&) const {}
    __device__ __forceinline__ void done(const Unit&) const {}
};
__device__ __forceinline__ unsigned cvt_pk_bf16(float lo, float hi) { unsigned r; asm volatile("v_cvt_pk_bf16_f32 %0, %1, %2" : "=v"(r) : "v"(lo), "v"(hi)); return r; }
template <class Epi, class Sched, bool ALIGN_EPI = false, bool SP2 = false>
__device__ __forceinline__ void gemm_phase(PG8_LAS unsigned char* lds, const Gemm g, const Sched& S, const Epi& E, int tid_in) {
    int tid_ = tid_in; asm volatile("" : "+v"(tid_)); const int tid = tid_, wid = __builtin_amdgcn_readfirstlane(tid >> 6), lane = tid & 63, wr = wid >> 2, wc = wid & 3, fr = lane & 15, fq = lane >> 4;
    const int K = g.K, nt = K / BK;
    unsigned voffA[2], voffB[2];
#pragma unroll
    for (int i = 0; i < 2; ++i) { int R, C; stage_rc(tid * 16 + i * 8192, R, C); const int Rb = Epi::PERM ? ((R & ~31) + perm32(R & 31)) : R;
        voffA[i] = (unsigned)(R * K + C) * 2u; voffB[i] = (unsigned)(Rb * K + C) * 2u; }
    const size_t kstep = (size_t)(BK * 2);
    const size_t hstep = (size_t)HALF * K * 2;
    const size_t tstep = 2 * hstep;
    const unsigned ldsw = (unsigned)wid * 1024u;
    const int aoff = lds_byte(wr * 64 + fr, fq * 8), boff = lds_byte(wc * 32 + fr, fq * 8);
#define PG8_SA(b, h) (((b) * 2 + (h)) * HTB)
#define PG8_SB(b, h) ((4 + (b) * 2 + (h)) * HTB)
#define PG8_STAGE(bufoff, gbase, voff) do { _Pragma("unroll") for (int _i = 0; _i < 2; ++_i) \
        __builtin_amdgcn_global_load_lds((const unsigned*)((const char*)(gbase) + (voff)[_i]), (PG8_LAS unsigned*)(lds + (bufoff) + ldsw + _i * 8192), 16, 0, 0); } while (0)
#define PG8_LDA(dst, b, h) do { _Pragma("unroll") for (int m = 0; m < 4; ++m) _Pragma("unroll") for (int k = 0; k < 2; ++k) dst[m][k] = *(const PG8_LAS bf16x8*)(lds + PG8_SA(b, h) + aoff + m * 2048 + k * 1024); } while (0)
#define PG8_LDB(dst, b, h) do { _Pragma("unroll") for (int n = 0; n < 2; ++n) _Pragma("unroll") for (int k = 0; k < 2; ++k) dst[n][k] = *(const PG8_LAS bf16x8*)(lds + PG8_SB(b, h) + boff + n * 2048 + k * 1024); } while (0)
#define PG8_MMA(ai, bj, At, Bt) do { __builtin_amdgcn_s_setprio(1); _Pragma("unroll") for (int m = 0; m < 4; ++m) _Pragma("unroll") for (int n = 0; n < 2; ++n) _Pragma("unroll") for (int k = 0; k < 2; ++k) \
        acc[ai][bj][m][n] = __builtin_amdgcn_mfma_f32_16x16x32_bf16(Bt[n][k], At[m][k], acc[ai][bj][m][n], 0, 0, 0); __builtin_amdgcn_s_setprio(0); } while (0)
#define PG8_WAIT_V(n) asm volatile("s_waitcnt vmcnt(" #n ")" ::: "memory")
#define PG8_WAIT_L(n) asm volatile("s_waitcnt lgkmcnt(" #n ")" ::: "memory")
#define PG8_BAR __builtin_amdgcn_s_barrier()
#define PG8_SCHED __builtin_amdgcn_sched_barrier(0)
    Unit cur, nxt; int ui = 0;
    if (!S.next(0, cur)) return;
    f32x4 acc[2][2][4][2];
#pragma unroll
    for (int a = 0; a < 2; ++a)
#pragma unroll
        for (int b = 0; b < 2; ++b)
#pragma unroll
            for (int m = 0; m < 4; ++m)
#pragma unroll
                for (int n = 0; n < 2; ++n) acc[a][b][m][n] = (f32x4){0.f, 0.f, 0.f, 0.f};
    bf16x8 At[4][2], B0[2][2], B1[2][2];
    const char* cA = (const char*)g.A + (size_t)cur.pm * tstep; const char* cB = (const char*)g.Bt + (size_t)cur.pn * tstep;
    S.a_ready(cur);
    if constexpr (SP2) {
        PG8_STAGE(PG8_SB(0, 0), cB, voffB); PG8_STAGE(PG8_SB(0, 1), cB + hstep, voffB); PG8_STAGE(PG8_SA(0, 0), cA, voffA); PG8_STAGE(PG8_SA(0, 1), cA + hstep, voffA);
        if (wr == 1) PG8_BAR;
        PG8_WAIT_V(2); PG8_BAR;
        PG8_STAGE(PG8_SB(1, 0), cB + kstep, voffB); PG8_STAGE(PG8_SA(1, 0), cA + kstep, voffA); PG8_STAGE(PG8_SB(1, 1), cB + hstep + kstep, voffB);
        PG8_WAIT_V(6); PG8_BAR;
    } else {
        PG8_STAGE(PG8_SB(0, 0), cB, voffB); PG8_STAGE(PG8_SA(0, 0), cA, voffA); PG8_STAGE(PG8_SB(0, 1), cB + hstep, voffB); PG8_STAGE(PG8_SA(0, 1), cA + hstep, voffA);
        if (wr == 1) PG8_BAR;
        PG8_WAIT_V(4); PG8_BAR;
        PG8_STAGE(PG8_SB(1, 0), cB + kstep, voffB); PG8_STAGE(PG8_SA(1, 0), cA + kstep, voffA); PG8_STAGE(PG8_SB(1, 1), cB + hstep + kstep, voffB);
        PG8_WAIT_V(6); PG8_BAR;
    }
    for (;;) {
        const bool has_next = S.next(ui + 1, nxt);
        const char* nA = has_next ? (const char*)g.A + (size_t)nxt.pm * tstep : cA; const char* nB = has_next ? (const char*)g.Bt + (size_t)nxt.pn * tstep : cB;
        for (int t = 0; t < nt; t += 2) {
            const bool last = (t == nt - 2);
            const char* a1 = cA + (size_t)(t + 1) * kstep;
            const char* a2 = last ? nA : cA + (size_t)(t + 2) * kstep; const char* b2 = last ? nB : cB + (size_t)(t + 2) * kstep;
            const char* a3 = a2 + kstep; const char* b3 = b2 + kstep;
            if constexpr (Epi::MIDK) { if (t > 0 && (t & 15) == 0) { unsigned mk2_ = ~0u; asm volatile("" : "+s"(mk2_)); const int l3_ = (int)__builtin_amdgcn_mbcnt_hi(mk2_, __builtin_amdgcn_mbcnt_lo(mk2_, 0u)); E.mid(acc, cur, t >> 4, wr, wc, l3_ & 15, l3_ >> 4); } }
            if (last && has_next) S.a_ready(nxt);
            if constexpr (SP2) {
            PG8_LDB(B0, 0, 0); PG8_LDB(B1, 0, 1); PG8_SCHED; PG8_LDA(At, 0, 0); PG8_STAGE(PG8_SA(1, 1), a1 + hstep, voffA);
            PG8_WAIT_V(8); PG8_WAIT_L(0); PG8_BAR; PG8_MMA(0, 0, At, B0); PG8_MMA(0, 1, At, B1); PG8_BAR; PG8_SCHED;
            PG8_LDA(At, 0, 1); PG8_STAGE(PG8_SB(0, 0), b2, voffB); PG8_STAGE(PG8_SB(0, 1), b2 + hstep, voffB); PG8_STAGE(PG8_SA(0, 0), a2, voffA);
            PG8_WAIT_V(8); PG8_WAIT_L(0); PG8_BAR; PG8_MMA(1, 0, At, B0); PG8_MMA(1, 1, At, B1); PG8_BAR; PG8_SCHED;
            PG8_LDB(B0, 1, 0); PG8_LDB(B1, 1, 1); PG8_SCHED; PG8_LDA(At, 1, 0); PG8_STAGE(PG8_SA(0, 1), a2 + hstep, voffA);
            PG8_WAIT_V(8); PG8_WAIT_L(0); PG8_BAR; PG8_MMA(0, 0, At, B0); PG8_MMA(0, 1, At, B1); PG8_BAR; PG8_SCHED;
            PG8_LDA(At, 1, 1); PG8_STAGE(PG8_SB(1, 0), b3, voffB); PG8_STAGE(PG8_SB(1, 1), b3 + hstep, voffB); PG8_STAGE(PG8_SA(1, 0), a3, voffA);
            PG8_WAIT_V(8); PG8_WAIT_L(0); PG8_BAR; PG8_MMA(1, 0, At, B0); PG8_MMA(1, 1, At, B1); PG8_BAR; PG8_SCHED;
            } else {
            PG8_LDB(B0, 0, 0); PG8_SCHED; PG8_LDA(At, 0, 0); PG8_STAGE(PG8_SA(1, 1), a1 + hstep, voffA);
            PG8_WAIT_L(8); PG8_BAR; PG8_WAIT_L(0); PG8_MMA(0, 0, At, B0); PG8_BAR; PG8_SCHED;
            PG8_LDB(B1, 0, 1); PG8_STAGE(PG8_SB(0, 0), b2, voffB);
            PG8_BAR; PG8_WAIT_L(0); PG8_MMA(0, 1, At, B1); PG8_BAR;
            PG8_LDA(At, 0, 1); PG8_STAGE(PG8_SA(0, 0), a2, voffA);
            PG8_BAR; PG8_WAIT_L(0); PG8_MMA(1, 0, At, B0); PG8_BAR; PG8_SCHED;
            PG8_STAGE(PG8_SB(0, 1), b2 + hstep, voffB);
            PG8_WAIT_V(6); PG8_BAR; PG8_MMA(1, 1, At, B1); PG8_BAR;
            PG8_LDB(B0, 1, 0); PG8_SCHED; PG8_LDA(At, 1, 0); PG8_STAGE(PG8_SA(0, 1), a2 + hstep, voffA);
            PG8_WAIT_L(8); PG8_BAR; PG8_WAIT_L(0); PG8_MMA(0, 0, At, B0); PG8_BAR; PG8_SCHED;
            PG8_LDB(B1, 1, 1); PG8_STAGE(PG8_SB(1, 0), b3, voffB);
            PG8_BAR; PG8_WAIT_L(0); PG8_MMA(0, 1, At, B1); PG8_BAR;
            PG8_LDA(At, 1, 1); PG8_STAGE(PG8_SA(1, 0), a3, voffA);
            PG8_BAR; PG8_WAIT_L(0); PG8_MMA(1, 0, At, B0); PG8_BAR; PG8_SCHED;
            PG8_STAGE(PG8_SB(1, 1), b3 + hstep, voffB);
            PG8_WAIT_V(6); PG8_BAR; PG8_MMA(1, 1, At, B1); PG8_BAR;
            }
        }
        if constexpr (ALIGN_EPI) { if (wr == 0) PG8_BAR; }
        if constexpr (!Epi::AFTER_DRAIN) { unsigned mk_ = ~0u; asm volatile("" : "+s"(mk_)); const int l2_ = (int)__builtin_amdgcn_mbcnt_hi(mk_, __builtin_amdgcn_mbcnt_lo(mk_, 0u));
            E(acc, cur, wr, wc, l2_ & 15, l2_ >> 4); S.done(cur); }
        if (!has_next) break;
#pragma unroll
        for (int a = 0; a < 2; ++a)
#pragma unroll
            for (int b = 0; b < 2; ++b)
#pragma unroll
                for (int m = 0; m < 4; ++m)
#pragma unroll
                    for (int n = 0; n < 2; ++n) acc[a][b][m][n] = (f32x4){0.f, 0.f, 0.f, 0.f};
        cur = nxt; cA = nA; cB = nB; ++ui;
        if constexpr (ALIGN_EPI) { if (wr == 1) PG8_BAR; }
    }
    PG8_WAIT_V(0);
    if constexpr (!ALIGN_EPI) { if (wr == 0) PG8_BAR; }
    PG8_BAR;
    if constexpr (Epi::AFTER_DRAIN) { E.fused(acc, cur, wr, wc, fr, fq, lds, wid, lane); S.done(cur); }
#undef PG8_SA
#undef PG8_SB
#undef PG8_STAGE
#undef PG8_LDA
#undef PG8_LDB
#undef PG8_MMA
#undef PG8_WAIT_V
#undef PG8_WAIT_L
#undef PG8_BAR
#undef PG8_SCHED
}
}
namespace pg8 {
__device__ __forceinline__ size_t gate_frag(int tile, int ai, int m, int bj, int wave, int lane) { return (size_t)tile * 65536 + (size_t)((((ai * 4 + m) * 2 + bj) * 8 + wave) * 512 + lane * 8); }
struct EpiInProj {
    static constexpr bool PERM = true, AFTER_DRAIN = false, MIDK = false;
    bf16_t* P1; unsigned char* G; float* DTR; float* GLR;
    __device__ __forceinline__ void operator()(const f32x4 (&acc)[2][2][4][2], const Unit& u, int wr, int wc, int fr, int fq) const {
        const int row0 = u.pm * BM + wr * 64 + fr;
        if (u.pn == 74) {
            if (wc < 2) {
                float* dst = (wc == 0) ? DTR : GLR;
#pragma unroll
                for (int ai = 0; ai < 2; ++ai)
#pragma unroll
                    for (int m = 0; m < 4; ++m) { float* rp = dst + (size_t)(row0 + ai * HALF + m * 16) * 32 + 8 * fq;
                        *(f32x4*)(rp) = acc[ai][0][m][0]; *(f32x4*)(rp + 4) = acc[ai][0][m][1]; }
            }
            return;
        }
        const bool gate = u.pn >= 42;
        const int colt = (gate ? (u.pn - 42) : u.pn) * BM;
        const int col0 = colt + wc * 32 + 8 * fq;
        if (gate) {
#pragma unroll
            for (int ai = 0; ai < 2; ++ai)
#pragma unroll
                for (int m = 0; m < 4; ++m) {
#pragma unroll
                    for (int bj = 0; bj < 2; ++bj) { unsigned char* rowp = G + gate_frag(u.pm * 32 + (u.pn - 42), ai, m, bj, wr * 4 + wc, fq * 16 + fr) - bj * HALF; const f32x4 v0 = acc[ai][bj][m][0], v1 = acc[ai][bj][m][1]; unsigned q[8];
#pragma unroll
                        for (int j = 0; j < 4; ++j) { q[j] = (unsigned)fmaxf(__builtin_rintf(255.f * sigmf(v0[j])), 1.f); q[4 + j] = (unsigned)fmaxf(__builtin_rintf(255.f * sigmf(v1[j])), 1.f); }
                        u32x2 w; w.x = q[0] | (q[1] << 8) | (q[2] << 16) | (q[3] << 24); w.y = q[4] | (q[5] << 8) | (q[6] << 16) | (q[7] << 24);
                        __builtin_nontemporal_store(w, (u32x2*)(rowp + bj * HALF)); } }
            return;
        }
#pragma unroll
        for (int ai = 0; ai < 2; ++ai)
#pragma unroll
            for (int m = 0; m < 4; ++m) { bf16_t* rowp = P1 + (size_t)(row0 + ai * HALF + m * 16) * P1W + col0;
#pragma unroll
                for (int bj = 0; bj < 2; ++bj) { const f32x4 v0 = acc[ai][bj][m][0], v1 = acc[ai][bj][m][1];
                    u32x4 w; w.x = cvt_pk_bf16(v0[0], v0[1]); w.y = cvt_pk_bf16(v0[2], v0[3]); w.z = cvt_pk_bf16(v1[0], v1[1]); w.w = cvt_pk_bf16(v1[2], v1[3]);
                    __builtin_nontemporal_store(w, (u32x4*)(rowp + bj * HALF)); } }
    }
};
struct EpiMerge {
    static constexpr bool PERM = true, AFTER_DRAIN = false, MIDK = true;
    const unsigned char* G; bf16_t* MB;
    __device__ __forceinline__ void mid(f32x4 (&acc)[2][2][4][2], const Unit& u, int nb  , int wr, int wc, int fr, int fq) const {
        const int row0 = u.pm * BM + wr * 64 + fr, col0 = u.pn * BM + wc * 32 + 8 * fq;
#pragma unroll
        for (int ai = 0; ai < 2; ++ai)
#pragma unroll
            for (int m = 0; m < 4; ++m) {
#pragma unroll
                for (int bj = 0; bj < 2; ++bj) { const unsigned char* gp = G + gate_frag(u.pm * 32 + (nb - 1) * 8 + u.pn, ai, m, bj, wr * 4 + wc, fq * 16 + fr);
                    const u32x2 a = *(const u32x2*)gp, b = *(const u32x2*)(gp + (size_t)8 * 65536);
                    f32x4& v0 = acc[ai][bj][m][0]; f32x4& v1 = acc[ai][bj][m][1];
#pragma unroll
                    for (int j = 0; j < 4; ++j) { v0[j] *= (float)((a.x >> (8 * j)) & 255u) * __builtin_amdgcn_rcpf((float)((b.x >> (8 * j)) & 255u));
                        v1[j] *= (float)((a.y >> (8 * j)) & 255u) * __builtin_amdgcn_rcpf((float)((b.y >> (8 * j)) & 255u)); } } }
    }
    __device__ __forceinline__ void operator()(const f32x4 (&acc)[2][2][4][2], const Unit& u, int wr, int wc, int fr, int fq) const {
        const int row0 = u.pm * BM + wr * 64 + fr, col0 = u.pn * BM + wc * 32 + 8 * fq;
#pragma unroll
        for (int ai = 0; ai < 2; ++ai)
#pragma unroll
            for (int m = 0; m < 4; ++m) { const size_t r = (size_t)(row0 + ai * HALF + m * 16);
#pragma unroll
                for (int bj = 0; bj < 2; ++bj) { const int c = col0 + bj * HALF;
                    const u32x2 gw = *(const u32x2*)(G + gate_frag(u.pm * 32 + 24 + u.pn, ai, m, bj, wr * 4 + wc, fq * 16 + fr));
                    f32x4 v0 = acc[ai][bj][m][0], v1 = acc[ai][bj][m][1];
#pragma unroll
                    for (int j = 0; j < 4; ++j) { v0[j] *= (float)((gw.x >> (8 * j)) & 255u) * (1.f / 255.f); v1[j] *= (float)((gw.y >> (8 * j)) & 255u) * (1.f / 255.f); }
                    u32x4 w; w.x = cvt_pk_bf16(v0[0], v0[1]); w.y = cvt_pk_bf16(v0[2], v0[3]); w.z = cvt_pk_bf16(v1[0], v1[1]); w.w = cvt_pk_bf16(v1[2], v1[3]);
                    __builtin_nontemporal_store(w, (u32x4*)(MB + r * DM + c)); } }
    }
};
struct EpiResid {
    static constexpr bool PERM = false, AFTER_DRAIN = false, MIDK = false;
    const float* xi; float* xo; const float* ci; float* co; const float* mod;   int which;
    __device__ __forceinline__ void operator()(const f32x4 (&acc)[2][2][4][2], const Unit& u, int wr, int wc, int fr, int fq) const {
        const int row0 = u.pm * BM + wr * 64 + fr, col0 = u.pn * BM + wc * 32 + 4 * fq;
#pragma unroll
        for (int ai = 0; ai < 2; ++ai)
#pragma unroll
            for (int m = 0; m < 4; ++m) { const int r = row0 + ai * HALF + m * 16;
                const bool lat = r < RX; const int j = lat ? (r >> 12) : 4;
                const float* ip = lat ? xi + (size_t)r * DM : ci + (size_t)(r - RX) * DM; float* op = lat ? xo + (size_t)r * DM : co + (size_t)(r - RX) * DM;
                const float* gp = mod + ((size_t)j * 6 + which) * DM;
#pragma unroll
                for (int bj = 0; bj < 2; ++bj)
#pragma unroll
                    for (int n = 0; n < 2; ++n) { const int c = col0 + bj * HALF + n * 16;
                        const f32x4 g = *(const f32x4*)(gp + c); const f32x4 x = *(const f32x4*)(ip + c);
                        *(f32x4*)(op + c) = x + g * acc[ai][bj][m][n]; } }
    }
};
struct EpiDelta {
    static constexpr bool PERM = true, AFTER_DRAIN = false, MIDK = false;
    bf16_t* D; const float* mod;   int which;
    __device__ __forceinline__ void operator()(const f32x4 (&acc)[2][2][4][2], const Unit& u, int wr, int wc, int fr, int fq) const {
        const int row0 = u.pm * BM + wr * 64 + fr, col0 = u.pn * BM + wc * 32 + 8 * fq;
#pragma unroll
        for (int ai = 0; ai < 2; ++ai)
#pragma unroll
            for (int m = 0; m < 4; ++m) { const int r = row0 + ai * HALF + m * 16; const int j = (r < RX) ? (r >> 12) : 4;
                const float* gp = mod + ((size_t)j * 6 + which) * DM;
#pragma unroll
                for (int bj = 0; bj < 2; ++bj) { const int c = col0 + bj * HALF; const f32x4 g0 = *(const f32x4*)(gp + c), g1 = *(const f32x4*)(gp + c + 4);
                    const f32x4 v0 = g0 * acc[ai][bj][m][0], v1 = g1 * acc[ai][bj][m][1];
                    u32x4 w; w.x = cvt_pk_bf16(v0[0], v0[1]); w.y = cvt_pk_bf16(v0[2], v0[3]); w.z = cvt_pk_bf16(v1[0], v1[1]); w.w = cvt_pk_bf16(v1[2], v1[3]);
                    __builtin_nontemporal_store(w, (u32x4*)(D + (size_t)r * DM + c)); } }
    }
};
struct EpiBf16P {
    static constexpr bool PERM = true, AFTER_DRAIN = false, MIDK = false;
    bf16_t* O; int ldc;
    __device__ __forceinline__ void operator()(const f32x4 (&acc)[2][2][4][2], const Unit& u, int wr, int wc, int fr, int fq) const {
        const int row0 = u.pm * BM + wr * 64 + fr, col0 = u.pn * BM + wc * 32 + 8 * fq;
#pragma unroll
        for (int ai = 0; ai < 2; ++ai)
#pragma unroll
            for (int m = 0; m < 4; ++m) { bf16_t* rowp = O + (size_t)(row0 + ai * HALF + m * 16) * ldc + col0;
#pragma unroll
                for (int bj = 0; bj < 2; ++bj) { const f32x4 v0 = acc[ai][bj][m][0], v1 = acc[ai][bj][m][1];
                    u32x4 w; w.x = cvt_pk_bf16(v0[0], v0[1]); w.y = cvt_pk_bf16(v0[2], v0[3]); w.z = cvt_pk_bf16(v1[0], v1[1]); w.w = cvt_pk_bf16(v1[2], v1[3]);
                    __builtin_nontemporal_store(w, (u32x4*)(rowp + bj * HALF)); } }
    }
};
struct EpiF32 {
    static constexpr bool PERM = false, AFTER_DRAIN = false, MIDK = false;
    float* C; int ldc;
    __device__ __forceinline__ void operator()(const f32x4 (&acc)[2][2][4][2], const Unit& u, int wr, int wc, int fr, int fq) const {
        const int row0 = u.pm * BM + wr * 64 + fr, col0 = u.pn * BM + wc * 32 + 4 * fq;
#pragma unroll
        for (int ai = 0; ai < 2; ++ai)
#pragma unroll
            for (int m = 0; m < 4; ++m) { float* rowp = C + (size_t)(row0 + ai * HALF + m * 16) * ldc + col0;
#pragma unroll
                for (int bj = 0; bj < 2; ++bj)
#pragma unroll
                    for (int n = 0; n < 2; ++n) *(f32x4*)(rowp + bj * HALF + n * 16) = acc[ai][bj][m][n]; }
    }
};
}
struct Params { const float* in[31]; float* out; unsigned char* ws; int ph_lo, ph_hi; };
enum { I_X = 0, I_C, I_CTX, I_CCTX, I_WADA, I_BADA, I_GN1, I_GN2, I_WIN, I_CONVW, I_CONVB, I_ALOG, I_DTB, I_SSDD, I_SSDNG, I_NAQN, I_NAKN, I_RPB,
       I_GLAWG, I_GLABG, I_GLANG, I_SWAQN, I_SWAKN, I_SINK, I_WBR, I_WOUT, I_PWQ, I_PK1, I_PK2, I_PU, I_PV };
struct Frame {
    const float* const* in; float* out; unsigned char* ws; LAS unsigned char* lds; unsigned char* ldsg;
    int tid, lane, wave, G, bid;
    __device__ __forceinline__ unsigned* ctl() const { return (unsigned*)(ws + WS_CTL); }
    __device__ __forceinline__ float* mod() const { return (float*)(ws + WS_MOD); }
    __device__ __forceinline__ bf16_t* win() const { return (bf16_t*)(ws + WS_WIN); }
    __device__ __forceinline__ bf16_t* wbr() const { return (bf16_t*)(ws + WS_WBR); }
    __device__ __forceinline__ bf16_t* wout() const { return (bf16_t*)(ws + WS_WOUT); }
    __device__ __forceinline__ bf16_t* wq() const { return (bf16_t*)(ws + WS_WQ); }
    __device__ __forceinline__ bf16_t* hn() const { return (bf16_t*)(ws + WS_HN); }
    __device__ __forceinline__ bf16_t* p1() const { return (bf16_t*)(ws + WS_P1); }
    __device__ __forceinline__ bf16_t* g() const { return (bf16_t*)(ws + WS_G); }
    __device__ __forceinline__ bf16_t* ys() const { return (bf16_t*)(ws + WS_YS); }
    __device__ __forceinline__ bf16_t* og() const { return (bf16_t*)(ws + WS_OG); }
    __device__ __forceinline__ bf16_t* outs() const { return (bf16_t*)(ws + WS_OUTS); }
    __device__ __forceinline__ bf16_t* mb() const { return (bf16_t*)(ws + WS_MB); }
    __device__ __forceinline__ float* dtr() const { return (float*)(ws + WS_DTR); }
    __device__ __forceinline__ float* glr() const { return (float*)(ws + WS_GLR); }
    __device__ __forceinline__ float* dt() const { return (float*)(ws + WS_DT); }
    __device__ __forceinline__ float* ctxs() const { return (float*)(ws + WS_CTXS); }
    __device__ __forceinline__ float* mp() const { return (float*)(ws + WS_MP); }
    __device__ __forceinline__ float* qp() const { return (float*)(ws + WS_QP); }
    __device__ __forceinline__ float* gate() const { return (float*)(ws + WS_GATE); }
    __device__ __forceinline__ int* idx() const { return (int*)(ws + WS_IDX); }
    __device__ __forceinline__ bf16_t* vtna() const { return (bf16_t*)(ws + WS_VTNA); }
    __device__ __forceinline__ bf16_t* vtsw() const { return (bf16_t*)(ws + WS_VTSW); }
    __device__ __forceinline__ float* gcum() const { return (float*)(ws + WS_GCUM); }
    __device__ __forceinline__ float* csum() const { return (float*)(ws + WS_CSUM); }
    int wave0; const float* const* in0; unsigned char* ws0;
    __device__ __forceinline__ void relaunder() { size_t z = 0; asm volatile("" : "+s"(z)); ws = ws0 + z; }
    __device__ __forceinline__ void init_ids() { wave0 = __builtin_amdgcn_readfirstlane((int)threadIdx.x >> 6); }
    __device__ __forceinline__ void refresh(unsigned char* w) { unsigned mk = ~0u; asm volatile("" : "+s"(mk)); int ln = (int)__builtin_amdgcn_mbcnt_hi(mk, __builtin_amdgcn_mbcnt_lo(mk, 0u));
        int wv = wave0; asm volatile("" : "+s"(wv)); lane = ln; wave = wv; tid = wv * 64 + ln;
        ws0 = w; size_t z = 0; asm volatile("" : "+s"(z)); ws = w + z; }
};
__device__ __forceinline__ int next_unit(Frame& F, int qslot) {
    volatile LAS int* w = (volatile LAS int*)(F.lds + 147440);
    __syncthreads();
    if (F.tid == 0) *w = (int)__hip_atomic_fetch_add(F.ctl() + CW_Q + 64 * qslot, 1u, __ATOMIC_RELAXED, __HIP_MEMORY_SCOPE_AGENT);
    __syncthreads();
    return __builtin_amdgcn_readfirstlane(*w);
}

__device__ __forceinline__ void phase_mod(Frame& F) {
    float* sc = (float*)F.ldsg;
    float* red = (float*)(F.ldsg + 40960);
    for (int i = F.tid; i < 5 * DM; i += 512) { const int j = i / DM, k = i % DM; const float v = (j < 4) ? F.in[I_C][j * DM + k] : F.in[I_CCTX][k]; sc[i] = siluf(v); }
    __syncthreads();
    const int kq = F.tid >> 5, cq = F.tid & 31;
    for (int u = F.bid; u < DEPTH * 96; u += F.G) {
        const int l = u / 96, cb = u % 96, col = cb * 128 + cq * 4;
        const float* w = F.in[I_WADA] + (size_t)l * DM * (6 * DM) + col;
        f32x4 a[5];
#pragma unroll
        for (int j = 0; j < 5; ++j) a[j] = (f32x4){0.f, 0.f, 0.f, 0.f};
#pragma unroll 4
        for (int k = kq; k < DM; k += 16) { const f32x4 wv = *(const f32x4*)(w + (size_t)k * (6 * DM));
#pragma unroll
            for (int j = 0; j < 5; ++j) a[j] += sc[j * DM + k] * wv; }
#pragma unroll
        for (int j = 0; j < 5; ++j) *(f32x4*)(red + (kq * 5 + j) * 128 + cq * 4) = a[j];
        __syncthreads();
        for (int o = F.tid; o < 5 * 128; o += 512) { const int j = o >> 7, c = o & 127; float s = 0.f;
#pragma unroll
            for (int q = 0; q < 16; ++q) s += red[(q * 5 + j) * 128 + c];
            F.mod()[((size_t)(l * 5 + j)) * (6 * DM) + cb * 128 + c] = s + F.in[I_BADA][(size_t)l * 6 * DM + cb * 128 + c]; }
        __syncthreads();
    }
}

__device__ __forceinline__ int win_orig_col(int n) {
    if (n < 3072) return n; if (n < 9216) return n + 32; if (n < 18944) return n + 64; if (n < 18976) return n - 18944 + 3072; if (n < 19008) return n - 18976 + 9248; return -1;
}
struct CvtTile { const float* src; bf16_t* dst; int ldsrc, K, k0, n0; bool remap; };
__device__ __forceinline__ CvtTile wcvt_desc(Frame& F, int l, int u) {
    constexpr int T_IN = 32 * (INP / 128), T_BR = 4 * 16 * 16, T_O = 32 * 16;
    CvtTile t;
    if (u < T_IN) { const int kt = u % 32, nt = u / 32; t = CvtTile{F.in[I_WIN] + (size_t)l * DM * INW, F.win(), INW, DM, kt * 64, nt * 128, true}; }
    else if (u < T_IN + T_BR) { const int v = u - T_IN, br = v >> 8, w = v & 255, kt = w % 16, nt = w / 16;
        t = CvtTile{F.in[I_WBR] + ((size_t)l * 4 + br) * 1024 * DM, F.wbr() + (size_t)br * 1024, DM, 4096, kt * 64, nt * 128, false}; }
    else if (u < T_IN + T_BR + T_O) { const int v = u - T_IN - T_BR, kt = v % 32, nt = v / 32; t = CvtTile{F.in[I_WOUT] + (size_t)l * DM * DM, F.wout(), DM, DM, kt * 64, nt * 128, false}; }
    else { const int v = u - T_IN - T_BR - T_O, kt = v % 32, nt = v / 32; t = CvtTile{F.in[I_PWQ] + (size_t)l * DM * DM, F.wq(), DM, DM, kt * 64, nt * 128, false}; }
    return t;
}
__device__ __forceinline__ void cvt_load(Frame& F, const CvtTile& t, f32x4 (&v)[4]) {
#pragma unroll
    for (int i = 0; i < 4; ++i) { const int e = F.tid + i * 512, kk = e >> 5, n4 = (e & 31) * 4; const int oc = t.remap ? win_orig_col(t.n0 + n4) : (t.n0 + n4);
        const int occ = oc >= 0 ? oc : 0; const f32x4 x = *(const f32x4*)(t.src + (size_t)(t.k0 + kk) * t.ldsrc + occ);
        v[i] = (oc >= 0) ? x : (f32x4){0.f, 0.f, 0.f, 0.f}; }
}
__device__ __forceinline__ void cvt_store(Frame& F, const CvtTile& t, const f32x4 (&v)[4]) {
    float* s = (float*)F.ldsg;
    __syncthreads();
#pragma unroll
    for (int i = 0; i < 4; ++i) { const int e = F.tid + i * 512, kk = e >> 5, n4 = (e & 31) * 4; *(f32x4*)(s + kk * 132 + n4) = v[i]; }
    __syncthreads();
#pragma unroll
    for (int i = 0; i < 2; ++i) { const int e = F.tid + i * 512, nn = e & 127, kc = (e >> 7) * 8;
        u32x4 w; w.x = pack2(s[(kc + 0) * 132 + nn], s[(kc + 1) * 132 + nn]); w.y = pack2(s[(kc + 2) * 132 + nn], s[(kc + 3) * 132 + nn]);
        w.z = pack2(s[(kc + 4) * 132 + nn], s[(kc + 5) * 132 + nn]); w.w = pack2(s[(kc + 6) * 132 + nn], s[(kc + 7) * 132 + nn]);
        *(u32x4*)(t.dst + (size_t)(t.n0 + nn) * t.K + t.k0 + kc) = w; }
}
__device__ __forceinline__ void phase_wcvt(Frame& F, int l) {
    constexpr int NT = 32 * (INP / 128) + 4 * 16 * 16 + 32 * 16 + 32 * 16;
    f32x4 va[4], vb[4];
    int u = F.bid;
    if (u >= NT) { __syncthreads(); return; }
    { const CvtTile t0 = wcvt_desc(F, l, u); cvt_load(F, t0, va); }
#pragma unroll 1
    for (; u < NT; u += 2 * F.G) {
        const int u1 = u + F.G, u2 = u + 2 * F.G;
        { const CvtTile tb = wcvt_desc(F, l, min(u1, NT - 1)); cvt_load(F, tb, vb); }
        { const CvtTile ta = wcvt_desc(F, l, u); cvt_store(F, ta, va); }
        { const CvtTile tc = wcvt_desc(F, l, min(u2, NT - 1)); cvt_load(F, tc, va); }
        if (u1 < NT) { const CvtTile tb = wcvt_desc(F, l, u1); cvt_store(F, tb, vb); }
    }
    __syncthreads();
}

__device__ __forceinline__ void phase_norm(Frame& F, int l, int which, const float* xs, const float* cs, int nrows, const bf16_t* delta = nullptr) {
    const float* g = F.in[which ? I_GN2 : I_GN1] + (size_t)l * DM;
    for (int row = F.bid * 8 + F.wave; row < nrows; row += F.G * 8) {
        const bool lat = row < RX; const int j = lat ? (row >> 12) : 4;
        const float* src = lat ? xs + (size_t)row * DM : cs + (size_t)(row - RX) * DM;
        const float* sh = F.mod() + ((size_t)(l * 5 + j) * 6 + which * 3 + 0) * DM; const float* sc = sh + DM;
        f32x4 v[8]; float ss = 0.f;
#pragma unroll
        for (int i = 0; i < 8; ++i) { v[i] = *(const f32x4*)(src + i * 256 + F.lane * 4);
            if (which == 1) { const u32x2 dw = *(const u32x2*)(delta + (size_t)row * DM + i * 256 + F.lane * 4); v[i][0] += lo2f(dw.x); v[i][1] += hi2f(dw.x); v[i][2] += lo2f(dw.y); v[i][3] += hi2f(dw.y); }
            ss += v[i][0] * v[i][0] + v[i][1] * v[i][1] + v[i][2] * v[i][2] + v[i][3] * v[i][3]; }
        ss = wsum(ss); const float r = rsqrtf(ss * (1.f / DM) + EPS);
#pragma unroll
        for (int i = 0; i < 8; ++i) { const int c = i * 256 + F.lane * 4; const f32x4 gg = *(const f32x4*)(g + c), s1 = *(const f32x4*)(sc + c), s0 = *(const f32x4*)(sh + c);
            const f32x4 h = v[i] * r * gg * (1.f + s1) + s0;
            u32x2 w; w.x = pack2(h[0], h[1]); w.y = pack2(h[2], h[3]); *(u32x2*)(F.hn() + (size_t)row * DM + c) = w;
            if (which == 1) {
                float am = fmaxf(fmaxf(fabsf(h[0]), fabsf(h[1])), fmaxf(fabsf(h[2]), fabsf(h[3])));
                am = fmaxf(am, xsw<16>(am)); am = fmaxf(am, xsw<8>(am)); am = fmaxf(am, xsw<4>(am)); am = fmaxf(am, xsw<2>(am)); am = fmaxf(am, xsw<1>(am));
                const float qs = (am > 0.f) ? 127.f / am : 0.f;
                const int q0 = (int)__builtin_rintf(h[0] * qs), q1 = (int)__builtin_rintf(h[1] * qs), q2 = (int)__builtin_rintf(h[2] * qs), q3 = (int)__builtin_rintf(h[3] * qs);
                unsigned char* gbq = (unsigned char*)F.g();
                *(unsigned*)(gbq + PE_HQ + (size_t)row * DM + c) = (unsigned)(q0 & 255) | ((unsigned)(q1 & 255) << 8) | ((unsigned)(q2 & 255) << 16) | ((unsigned)q3 << 24);
                if ((F.lane & 31) == 0) *(float*)(gbq + PE_HS + ((size_t)row * 16 + i * 2 + (F.lane >> 5)) * 4) = am * (1.f / 127.f); } }
    }
}

__device__ __forceinline__ void phase_prep(Frame& F, int l, bool dry = false) {
    const float* cw = F.in[I_CONVW] + (size_t)l * 5 * 2048; const float* cb = F.in[I_CONVB] + (size_t)l * 2048;
    bf16_t* xact = F.hn();
    const int v = F.tid >> 3, li = F.tid & 7;
    float* rct = (float*)(F.ldsg + 131072); float* rst = rct + 1024;
    __syncthreads();
    for (int e = F.tid; e < 1024; e += 512) { const int pp = e >> 4, f = e & 15; const float inv = expf(-(float)f * (9.210340371976184f / 16.f)); float sn, cs; sincosf((float)pp * inv, &sn, &cs); rct[e] = cs; rst[e] = sn; }
    __syncthreads();
    float wt[5][8], bias[8];
    { const int c = (F.tid & 255) * 8;
#pragma unroll
      for (int e = 0; e < 8; ++e) bias[e] = cb[c + e];
#pragma unroll
      for (int j = 0; j < 5; ++j)
#pragma unroll
        for (int e = 0; e < 8; ++e) wt[j][e] = cw[j * 2048 + c + e]; }
    for (int q4 = F.bid; q4 < MR / 4; q4 += F.G) {
        const int row0 = q4 * 4; const bool lat = row0 < RX; const int pos0 = lat ? (row0 & 4095) : ((row0 - RX) & 255), n = lat ? SEQ : LCTX;
        if (F.tid < 256) {
            const int c = F.tid * 8; u32x4 w[8];
#pragma unroll
            for (int j = 0; j < 8; ++j) { const int pq = pos0 + j - 2; w[j] = (pq >= 0 && pq < n) ? *(const u32x4*)(F.p1() + (size_t)(row0 + j - 2) * P1W + C_XBC + c) : (u32x4){0u, 0u, 0u, 0u}; }
#pragma unroll
            for (int rr = 0; rr < 4; ++rr) { float a[8];
#pragma unroll
                for (int e = 0; e < 8; ++e) a[e] = bias[e];
#pragma unroll
                for (int j = 0; j < 5; ++j) { const u32x4 ww = w[rr + j];
                    a[0] += lo2f(ww.x) * wt[j][0]; a[1] += hi2f(ww.x) * wt[j][1]; a[2] += lo2f(ww.y) * wt[j][2]; a[3] += hi2f(ww.y) * wt[j][3];
                    a[4] += lo2f(ww.z) * wt[j][4]; a[5] += hi2f(ww.z) * wt[j][5]; a[6] += lo2f(ww.w) * wt[j][6]; a[7] += hi2f(ww.w) * wt[j][7]; }
                u32x4 o; o.x = pack2(siluf(a[0]), siluf(a[1])); o.y = pack2(siluf(a[2]), siluf(a[3])); o.z = pack2(siluf(a[4]), siluf(a[5])); o.w = pack2(siluf(a[6]), siluf(a[7]));
                *(u32x4*)(xact + (size_t)(row0 + rr) * 2048 + c) = o; }
        }
        if (F.tid < 128) { const int rr = F.tid >> 5, c = F.tid & 31; const float x = F.dtr()[(size_t)(row0 + rr) * 32 + c] + F.in[I_DTB][l * 32 + c];
            F.dt()[(size_t)(row0 + rr) * 32 + c] = fmaxf(x, 0.f) + 0.6931471805599453f * __builtin_amdgcn_logf(1.f + __builtin_amdgcn_exp2f(-1.4426950408889634f * fabsf(x))); }
        {
            const bool act = v < 52; int coff; const float* gn; float scl = 1.f; bool rope = false;
            if (v < 16) { coff = C_NA + v * 64; gn = F.in[I_NAQN] + l * 64; scl = 0.125f; }
            else if (v < 32) { coff = C_NA + 1024 + (v - 16) * 64; gn = F.in[I_NAKN] + l * 64; }
            else if (v < 48) { coff = C_SQ + (v - 32) * 64; gn = F.in[I_SWAQN] + l * 64; scl = 0.125f; rope = lat; }
            else { coff = C_SK + ((v - 48) & 3) * 64; gn = F.in[I_SWAKN] + l * 64; rope = lat; }
            float gw[8];
#pragma unroll
            for (int e = 0; e < 8; ++e) gw[e] = gn[li * 8 + e];
            u32x4 wv[4];
#pragma unroll
            for (int rr = 0; rr < 4; ++rr) wv[rr] = act ? *(const u32x4*)(F.p1() + (size_t)(row0 + rr) * P1W + coff + li * 8) : (u32x4){0u, 0u, 0u, 0u};
#pragma unroll
            for (int rr = 0; rr < 4; ++rr) { const u32x4 w = wv[rr]; const int pos = pos0 + rr;
                float x[8] = {lo2f(w.x), hi2f(w.x), lo2f(w.y), hi2f(w.y), lo2f(w.z), hi2f(w.z), lo2f(w.w), hi2f(w.w)};
                float ss = 0.f;
#pragma unroll
                for (int e = 0; e < 8; ++e) ss += x[e] * x[e];
                ss += xsw<1>(ss); ss += xsw<2>(ss); ss += xsw<4>(ss);
                const float r = rsqrtf(ss * (1.f / 64.f) + EPS);
#pragma unroll
                for (int e = 0; e < 8; ++e) x[e] = x[e] * r * gw[e];
                float y[8];
#pragma unroll
                for (int e = 0; e < 8; ++e) y[e] = xsw<2>(x[e]);
                if (dry) { asm volatile("" :: "v"(x[0]), "v"(x[7]), "v"(y[3])); }
                if (rope) {
                    const int pc = (li < 4) ? (pos >> 6) : (pos & 63);
#pragma unroll
                    for (int e = 0; e < 8; ++e) { const int f = (li & 1) * 8 + e; const float cs = rct[pc * 16 + f], sn = rst[pc * 16 + f];
                        x[e] = (li & 2) ? (y[e] * sn + x[e] * cs) : (x[e] * cs - y[e] * sn); }
                }
                if (act && !dry) { u32x4 o; o.x = pack2(x[0] * scl, x[1] * scl); o.y = pack2(x[2] * scl, x[3] * scl); o.z = pack2(x[4] * scl, x[5] * scl); o.w = pack2(x[6] * scl, x[7] * scl);
                    *(u32x4*)(F.p1() + (size_t)(row0 + rr) * P1W + coff + li * 8) = o; }
            }
        }
    }
    for (int u = F.bid; u < 2 * (MR / 64); u += F.G) {
        const int dir = u & 1, rb = u >> 1, rowb = rb * 64;
        float* sgl = (float*)F.ldsg;
        __syncthreads();
        float* sdt = sgl + 1024;
        for (int e = F.tid; e < 1024; e += 512) { sgl[e] = F.glr()[(size_t)(rowb + (e >> 4)) * 32 + dir * 16 + (e & 15)]; sdt[e] = F.dtr()[(size_t)(rowb + (e >> 4)) * 32 + dir * 16 + (e & 15)]; }
        float wg[16];
#pragma unroll
        for (int k = 0; k < 16; ++k) wg[k] = F.in[I_GLAWG][(((size_t)l * 2 + dir) * 16 + k) * 512 + F.tid];
        const float bg = F.in[I_GLABG][((size_t)l * 2 + dir) * 512 + F.tid];
        __syncthreads();
#pragma unroll
        for (int hh = 0; hh < 2; ++hh) { const int head = F.wave * 2 + hh, r = dir ? 63 - F.lane : F.lane;
            const float a = -expf(F.in[I_ALOG][l * 32 + dir * 16 + head]), x = sdt[r * 16 + head] + F.in[I_DTB][l * 32 + dir * 16 + head];
            const float dtv = fmaxf(x, 0.f) + 0.6931471805599453f * __builtin_amdgcn_logf(1.f + __builtin_amdgcn_exp2f(-1.4426950408889634f * fabsf(x)));
            float tot = dtv * a, pre = tot, t;
            t = xsw<1>(tot); pre += (F.lane & 1) ? t : 0.f; tot += t;   t = xsw<2>(tot); pre += (F.lane & 2) ? t : 0.f; tot += t;   t = xsw<4>(tot); pre += (F.lane & 4) ? t : 0.f; tot += t;
            t = xsw<8>(tot); pre += (F.lane & 8) ? t : 0.f; tot += t;   t = xsw<16>(tot); pre += (F.lane & 16) ? t : 0.f; tot += t;   t = xsw<32>(tot); pre += (F.lane & 32) ? t : 0.f; tot += t;
            F.csum()[((size_t)dir * MR + rowb + r) * 16 + head] = pre; }
        float run = 0.f; float* gout = F.gcum() + ((size_t)dir * MR + rowb) * 512 + F.tid;
#pragma unroll 4
        for (int i = 0; i < 64; ++i) { const int r = dir ? 63 - i : i; float lg = bg;
            const f32x4 g0 = *(const f32x4*)(sgl + r * 16), g1 = *(const f32x4*)(sgl + r * 16 + 4), g2 = *(const f32x4*)(sgl + r * 16 + 8), g3 = *(const f32x4*)(sgl + r * 16 + 12);
            lg += g0[0] * wg[0] + g0[1] * wg[1] + g0[2] * wg[2] + g0[3] * wg[3]; lg += g1[0] * wg[4] + g1[1] * wg[5] + g1[2] * wg[6] + g1[3] * wg[7];
            lg += g2[0] * wg[8] + g2[1] * wg[9] + g2[2] * wg[10] + g2[3] * wg[11]; lg += g3[0] * wg[12] + g3[1] * wg[13] + g3[2] * wg[14] + g3[3] * wg[15];
            const float ls = fminf(lg, 0.f) - 0.6931471805599453f * __builtin_amdgcn_logf(1.f + __builtin_amdgcn_exp2f(-1.4426950408889634f * fabsf(lg)));
            run += ls * (1.f / 16.f); gout[(size_t)r * 512] = run; }
    }
    __syncthreads();
    for (int tile = F.bid; tile < MR / 32; tile += F.G) {
    {
        bf16_t* sv = (bf16_t*)F.ldsg;
        const int row0 = tile * 32; const bool lat = row0 < RX; const int b = lat ? (row0 >> 12) : ((row0 - RX) >> 8); const int tok0 = lat ? (row0 & 4095) : (SEQ + ((row0 - RX) & 255));
        __syncthreads();
        for (int e = F.tid; e < 32 * 160; e += 512) { const int r = e / 160, ch = e % 160; const int col = (ch < 128) ? (C_NA + 2048 + ch * 8) : (C_SV + (ch - 128) * 8);
            const u32x4 w = *(const u32x4*)(F.p1() + (size_t)(row0 + r) * P1W + col); unsigned* d = (unsigned*)(sv + r * 1282 + ch * 8); d[0] = w.x; d[1] = w.y; d[2] = w.z; d[3] = w.w; }
        __syncthreads();
        for (int e = F.tid; e < 1280 * 4; e += 512) { const int hd = e >> 2, q = e & 3;
            u32x4 o; unsigned short t8[8];
#pragma unroll
            for (int i = 0; i < 8; ++i) t8[i] = sv[(q * 8 + i) * 1282 + hd];
            o.x = t8[0] | ((unsigned)t8[1] << 16); o.y = t8[2] | ((unsigned)t8[3] << 16); o.z = t8[4] | ((unsigned)t8[5] << 16); o.w = t8[6] | ((unsigned)t8[7] << 16);
            const int d = hd & 63, tok = tok0 + q * 8, tile16 = tok >> 4, g0 = (tok & 15) >> 2;
            bf16_t* base = (hd < 1024) ? F.vtna() + (size_t)(b * 16 + (hd >> 6)) * 64 * VTS : F.vtsw() + (size_t)(b * 4 + ((hd - 1024) >> 6)) * 64 * VTS;
            *(u32x4*)(base + (((size_t)tile16 * 4 + (d >> 4)) * 16 + (d & 15)) * 16 + g0 * 4) = o; }
        __syncthreads();
    }
    }
}
#ifdef DBG_NAIVE
__global__ void __launch_bounds__(256) ssd_naive(Params P, int l) {
    Frame F; F.in = P.in; F.out = P.out; F.ws = P.ws; const int gid = blockIdx.x * 256 + threadIdx.x; if (gid >= 8192) return;
    const int p = gid & 63, dir = (gid >> 6) & 1, h = (gid >> 7) & 15, b = gid >> 11, grp = h >> 2;
    const bf16_t* xact = F.hn(); bf16_t* yout = F.ys() + (size_t)dir * MR * 1024;
    const float a = -expf(F.in[I_ALOG][l * 32 + dir * 16 + h]);
    float st[128];
#pragma unroll
    for (int n = 0; n < 128; ++n) st[n] = 0.f;
    for (int seg = 0; seg < 2; ++seg) { const int nn = seg ? SEQ : LCTX, base = seg ? b * SEQ : RX + b * LCTX;
        for (int i = 0; i < nn; ++i) { const int ps = dir ? (nn - 1 - i) : i; const size_t row = (size_t)(base + ps);
            const float dtv = F.dt()[row * 32 + dir * 16 + h], dec = expf(dtv * a), xv = bf2f(xact[row * 2048 + h * 64 + p]) * dtv; float y = 0.f;
#pragma unroll
            for (int n = 0; n < 128; ++n) { const float Bn = bf2f(xact[row * 2048 + 1024 + grp * 128 + n]), Cn = bf2f(xact[row * 2048 + 1536 + grp * 128 + n]); st[n] = dec * st[n] + xv * Bn; y += Cn * st[n]; }
            yout[row * 1024 + h * 64 + p] = f2bf(y); } }
}
__global__ void __launch_bounds__(256) gla_naive(Params P, int l) {
    Frame F; F.in = P.in; F.out = P.out; F.ws = P.ws; const int gid = blockIdx.x * 256 + threadIdx.x; if (gid >= 8192) return;
    const int v = gid & 255, dir = (gid >> 8) & 1, h = (gid >> 9) & 3, b = gid >> 11;
    bf16_t* oout = F.og() + (size_t)dir * MR * 1024;
    const float* wg = F.in[I_GLAWG] + ((size_t)l * 2 + dir) * 16 * 512 + h * 128; const float* bg = F.in[I_GLABG] + ((size_t)l * 2 + dir) * 512 + h * 128;
    float* S = (float*)(F.ws + WS_IDX) + gid;
    for (int k = 0; k < 128; ++k) S[k * 8192] = 0.f;
    for (int seg = 0; seg < 2; ++seg) { const int nn = seg ? SEQ : LCTX, base = seg ? b * SEQ : RX + b * LCTX;
        for (int i = 0; i < nn; ++i) { const int ps = dir ? (nn - 1 - i) : i; const size_t row = (size_t)(base + ps); const bf16_t* rp = F.p1() + row * P1W;
            float gl[16];
#pragma unroll
            for (int r = 0; r < 16; ++r) gl[r] = F.glr()[row * 32 + dir * 16 + r];
            const float vv = bf2f(rp[C_GV + h * 256 + v]); float o = 0.f;
#pragma unroll 1
            for (int k = 0; k < 128; ++k) { float lg = bg[k];
#pragma unroll
                for (int r = 0; r < 16; ++r) lg += gl[r] * wg[r * 512 + k];
                const float ls = fminf(lg, 0.f) - log1pf(expf(-fabsf(lg))); const float eg = expf(ls * (1.f / 16.f));
                const float sn = eg * S[k * 8192] + bf2f(rp[C_GK + h * 128 + k]) * vv; S[k * 8192] = sn; o += bf2f(rp[C_GQ + h * 128 + k]) * 0.08838834764831845f * sn; }
            oout[row * 1024 + h * 256 + v] = f2bf(o); } }
}
#endif
template <int MODE>
__device__ __forceinline__ void attn_task(Frame& F, int l, int b, int h, int qi, const float* srpb, float shift2, float sink2, bool has_sink, bf16_t* outb, int lane) {
    const int c = lane & 15, g = lane >> 4;
    constexpr bool NA = (MODE == 0 || MODE == 2);
    const int hk = NA ? h : (h >> 2);
    const int qcoff = NA ? (C_NA + h * 64) : (C_SQ + h * 64), kcoff = NA ? (C_NA + 1024 + h * 64) : (C_SK + hk * 64);
    const bf16_t* vt = NA ? F.vtna() + (size_t)(b * 16 + h) * 64 * VTS : F.vtsw() + (size_t)(b * 4 + hk) * 64 * VTS;
    int qrow0, r = 0, qt = 0, r0 = 0, ct0 = 0, tq = 0;
    if (MODE == 0) { r = qi >> 2; qt = qi & 3; qrow0 = b * SEQ + r * 64 + qt * 16; r0 = min(max(r - 4, 0), 56); ct0 = (qt >= 2) ? 1 : 0; }
    else if (MODE == 1) { tq = qi; qrow0 = b * SEQ + tq * 16; }
    else qrow0 = RX + b * LCTX + qi * 16;
    constexpr int NG = (MODE == 0) ? 20 : (MODE == 1) ? 17 : 8;
    const bf16_t* p1 = F.p1();
    bf16x8 qf[2];
#pragma unroll
    for (int s = 0; s < 2; ++s) qf[s] = *(const bf16x8*)(p1 + (size_t)(qrow0 + c) * P1W + qcoff + 32 * s + 8 * g);
    f32x4 O[4];
#pragma unroll
    for (int dt = 0; dt < 4; ++dt) O[dt] = (f32x4){0.f, 0.f, 0.f, 0.f};
    float lsum = 0.f;
    const int qc = qt * 16 + c, cs = min(max(qc - 8, 0), 48);
    const int qtok = tq * 16 + c;
    auto tile_of = [&](int ti, int& krow, int& vtile, bool& tok_ok, int& kr, int& kc0) {
        tok_ok = true; kr = 0; kc0 = 0;
        if (MODE == 0) { if (ti < 24) { const int kr_ = r0 + ti / 3, ct = ct0 + ti % 3; kr = kr_; kc0 = ct * 16; krow = b * SEQ + kr_ * 64 + ct * 16; vtile = kr_ * 4 + ct; }
                         else { krow = RX + b * LCTX + (ti - 24) * 16; vtile = 256 + (ti - 24); kr = -1; } }
        else if (MODE == 1) { if (ti < 17) { int tk = tq - 8 + ti; tok_ok = (tk >= 0 && tk < 256); tk = min(max(tk, 0), 255); kc0 = tk * 16; krow = b * SEQ + tk * 16; vtile = tk; }
                              else if (ti < 33) { krow = RX + b * LCTX + (ti - 17) * 16; vtile = 256 + (ti - 17); kr = -1; }
                              else { krow = RX + b * LCTX; vtile = 256; tok_ok = false; kr = -2; } }
        else { krow = RX + b * LCTX + ti * 16; vtile = 256 + ti; kr = -1; }
    };
    bf16x8 kf[2][2], kn[2][2]; u32x2 vf[4][2], vn[4][2];
    auto load_group = [&](int gi, bf16x8 (&K)[2][2], u32x2 (&V)[4][2]) {
#pragma unroll
        for (int tt = 0; tt < 2; ++tt) { int krow, vtile, kr, kc0; bool ok; tile_of(gi * 2 + tt, krow, vtile, ok, kr, kc0);
            const bf16_t* kp = p1 + (size_t)(krow + c) * P1W + kcoff + 8 * g; K[tt][0] = *(const bf16x8*)kp; K[tt][1] = *(const bf16x8*)(kp + 32);
#pragma unroll
            for (int dt = 0; dt < 4; ++dt) V[dt][tt] = *(const u32x2*)(vt + (((size_t)vtile * 4 + dt) * 16 + c) * 16 + 4 * g); }
    };
    load_group(0, kf, vf);
#pragma unroll 1
    for (int gi = 0; gi < NG; ++gi) {
        if (gi + 1 < NG) load_group(gi + 1, kn, vn);
        f32x4 S[2]; bool tok_ok[2]; int kr_[2], kc0_[2];
#pragma unroll
        for (int tt = 0; tt < 2; ++tt) { int krow, vtile; tile_of(gi * 2 + tt, krow, vtile, tok_ok[tt], kr_[tt], kc0_[tt]);
            S[tt] = __builtin_amdgcn_mfma_f32_16x16x32_bf16(kf[tt][0], qf[0], (f32x4){0.f, 0.f, 0.f, 0.f}, 0, 0, 0);
            S[tt] = __builtin_amdgcn_mfma_f32_16x16x32_bf16(kf[tt][1], qf[1], S[tt], 0, 0, 0); }
        float p[2][4];
#pragma unroll
        for (int tt = 0; tt < 2; ++tt)
#pragma unroll
            for (int rr = 0; rr < 4; ++rr) {
                float lg = S[tt][rr]; bool ok = tok_ok[tt];
                if (MODE == 0) { if (kr_[tt] >= 0) { const int kc = kc0_[tt] + 4 * g + rr; ok = (kc >= cs) && (kc < cs + 16); const int bi = (kr_[tt] - r + 7) * 31 + (kc - qc + 15); lg += ok ? srpb[bi] : 0.f; } }
                if (MODE == 1) { if (kr_[tt] == 0) { const int kt = kc0_[tt] + 4 * g + rr; const int dd = qtok - kt; ok = ok && (dd <= 128) && (dd >= -128); } }
                const float e = __builtin_amdgcn_exp2f(lg * 1.4426950408889634f - shift2);
                p[tt][rr] = ok ? e : 0.f; lsum += p[tt][rr];
            }
        u32x4 pw; pw.x = pg8::cvt_pk_bf16(p[0][0], p[0][1]); pw.y = pg8::cvt_pk_bf16(p[0][2], p[0][3]); pw.z = pg8::cvt_pk_bf16(p[1][0], p[1][1]); pw.w = pg8::cvt_pk_bf16(p[1][2], p[1][3]);
        const bf16x8 pb = __builtin_bit_cast(bf16x8, pw);
#pragma unroll
        for (int dt = 0; dt < 4; ++dt) { u32x4 vw; vw.x = vf[dt][0].x; vw.y = vf[dt][0].y; vw.z = vf[dt][1].x; vw.w = vf[dt][1].y;
            O[dt] = __builtin_amdgcn_mfma_f32_16x16x32_bf16(__builtin_bit_cast(bf16x8, vw), pb, O[dt], 0, 0, 0); }
#pragma unroll
        for (int tt = 0; tt < 2; ++tt) { kf[tt][0] = kn[tt][0]; kf[tt][1] = kn[tt][1];
#pragma unroll
            for (int dt = 0; dt < 4; ++dt) vf[dt][tt] = vn[dt][tt]; }
    }
    lsum += xsw<16>(lsum); lsum += xsw<32>(lsum);
    if (has_sink) lsum += __builtin_amdgcn_exp2f(sink2 - shift2);
    const float inv = 1.f / lsum;
    bf16_t* op = outb + (size_t)(qrow0 + c) * 4096 + h * 64 + 4 * g;
#pragma unroll
    for (int dt = 0; dt < 4; ++dt) { u32x2 w; w.x = pg8::cvt_pk_bf16(O[dt][0] * inv, O[dt][1] * inv); w.y = pg8::cvt_pk_bf16(O[dt][2] * inv, O[dt][3] * inv); *(u32x2*)(op + dt * 16) = w; }
}

#ifndef ATT_K2
#define ATT_K2 0
#endif
template <int MODE>
__device__ __forceinline__ void attn_task4(Frame& F, int l, int b, int hx_, int qi, const float* srpb, float shift2, const float* sinkp, bf16_t* outb, int lane) {
    const int c = lane & 15, g = lane >> 4;
    constexpr bool NA = (MODE == 0 || MODE == 2);
    const int h0 = NA ? hx_ : hx_ * 4;
    const int kcoff = NA ? (C_NA + 1024 + hx_ * 64) : (C_SK + hx_ * 64);
    const bf16_t* vt = NA ? F.vtna() + (size_t)(b * 16 + hx_) * 64 * VTS : F.vtsw() + (size_t)(b * 4 + hx_) * 64 * VTS;
    const int r = qi, r0 = min(max(r - 4, 0), 56), tq = qi;
    const bf16_t* p1 = F.p1();
    int qrow[4], qcol[4];
#pragma unroll
    for (int j = 0; j < 4; ++j) {
        if (MODE == 0) { qrow[j] = b * SEQ + r * 64 + j * 16; qcol[j] = C_NA + hx_ * 64; }
        else if (MODE == 2) { qrow[j] = RX + b * LCTX + (qi * 4 + j) * 16; qcol[j] = C_NA + hx_ * 64; }
        else if (MODE == 1) { qrow[j] = b * SEQ + tq * 16; qcol[j] = C_SQ + (h0 + j) * 64; }
        else { qrow[j] = RX + b * LCTX + qi * 16; qcol[j] = C_SQ + (h0 + j) * 64; } }
    bf16x8 qf[4][2];
#pragma unroll
    for (int j = 0; j < 4; ++j)
#pragma unroll
        for (int s = 0; s < 2; ++s) qf[j][s] = *(const bf16x8*)(p1 + (size_t)(qrow[j] + c) * P1W + qcol[j] + 32 * s + 8 * g);
    f32x4 O[4][4]; float lsum[4];
#pragma unroll
    for (int j = 0; j < 4; ++j) { lsum[j] = 0.f;
#pragma unroll
        for (int dt = 0; dt < 4; ++dt) O[j][dt] = (f32x4){0.f, 0.f, 0.f, 0.f}; }
    constexpr int NG = (MODE == 0) ? 24 : (MODE == 1) ? 17 : 8;
    const int qtok = tq * 16 + c;
    auto tile_of = [&](int gi, int tt, int& krow, int& vtile, bool& tok_ok, int& kr, int& kc0) {
        tok_ok = true; kr = -1; kc0 = 0;
        if (MODE == 0) { if (gi < 16) { const int kr_ = r0 + (gi >> 1), ct = (gi & 1) * 2 + tt; kr = kr_; kc0 = ct * 16; krow = b * SEQ + kr_ * 64 + ct * 16; vtile = kr_ * 4 + ct; }
                         else { const int ci = (gi - 16) * 2 + tt; krow = RX + b * LCTX + ci * 16; vtile = 256 + ci; } }
        else if (MODE == 1) { const int ti = gi * 2 + tt;
                              if (ti < 17) { int tk = tq - 8 + ti; tok_ok = (tk >= 0 && tk < 256); tk = min(max(tk, 0), 255); kr = 0; kc0 = tk * 16; krow = b * SEQ + tk * 16; vtile = tk; }
                              else if (ti < 33) { krow = RX + b * LCTX + (ti - 17) * 16; vtile = 256 + (ti - 17); }
                              else { krow = RX + b * LCTX; vtile = 256; tok_ok = false; kr = -2; } }
        else { const int ti = gi * 2 + tt; krow = RX + b * LCTX + ti * 16; vtile = 256 + ti; }
    };
    bf16x8 kf[2][2], kn[2][2], k2[2][2]; u32x2 vf[4][2], vn[4][2];
    auto load_k = [&](int gi, bf16x8 (&K)[2][2]) {
#pragma unroll
        for (int tt = 0; tt < 2; ++tt) { int krow, vtile, kr, kc0; bool ok; tile_of(gi, tt, krow, vtile, ok, kr, kc0);
            const bf16_t* kp = p1 + (size_t)(krow + c) * P1W + kcoff + 8 * g; K[tt][0] = *(const bf16x8*)kp; K[tt][1] = *(const bf16x8*)(kp + 32); }
    };
    auto load_v = [&](int gi, u32x2 (&V)[4][2]) {
#pragma unroll
        for (int tt = 0; tt < 2; ++tt) { int krow, vtile, kr, kc0; bool ok; tile_of(gi, tt, krow, vtile, ok, kr, kc0);
#pragma unroll
            for (int dt = 0; dt < 4; ++dt) V[dt][tt] = *(const u32x2*)(vt + (((size_t)vtile * 4 + dt) * 16 + c) * 16 + 4 * g); }
    };
    load_k(0, kf); load_v(0, vf);
#if ATT_K2
    load_k(1, kn);
#endif
#pragma unroll
    for (int j = 0; j < 4; ++j) asm volatile("" : "+v"(qf[j][0]), "+v"(qf[j][1]));
#pragma unroll
    for (int tt = 0; tt < 2; ++tt) { asm volatile("" : "+v"(kf[tt][0]), "+v"(kf[tt][1]));
#pragma unroll
        for (int dt = 0; dt < 4; ++dt) asm volatile("" : "+v"(vf[dt][tt])); }
#pragma unroll 1
    for (int gi = 0; gi < NG; ++gi) {
        if (gi + 1 < NG) load_v(gi + 1, vn);
#if ATT_K2
        if (gi + 2 < NG) load_k(gi + 2, k2);
#else
        if (gi + 1 < NG) load_k(gi + 1, kn);
#endif
        int gq = g, cq = c; asm volatile("" : "+v"(gq), "+v"(cq));
        bool tok_ok[2]; int kr_[2], kc0_[2];
#pragma unroll
        for (int tt = 0; tt < 2; ++tt) { int krow, vtile; tile_of(gi, tt, krow, vtile, tok_ok[tt], kr_[tt], kc0_[tt]); }
#pragma unroll
        for (int j = 0; j < 4; ++j) {
            bool rel = true;
            if (MODE == 0) { if (gi < 16) rel = ((gi & 1) == 0) ? (j <= 2) : (j >= 1); }
            if (rel) {
                f32x4 S[2];
#pragma unroll
                for (int tt = 0; tt < 2; ++tt) { S[tt] = __builtin_amdgcn_mfma_f32_16x16x32_bf16(kf[tt][0], qf[j][0], (f32x4){0.f, 0.f, 0.f, 0.f}, 0, 0, 0);
                    S[tt] = __builtin_amdgcn_mfma_f32_16x16x32_bf16(kf[tt][1], qf[j][1], S[tt], 0, 0, 0); }
                float p[2][4];
                const int qc = j * 16 + cq, cs = min(max(qc - 8, 0), 48);
#pragma unroll
                for (int tt = 0; tt < 2; ++tt)
#pragma unroll
                    for (int rr = 0; rr < 4; ++rr) {
                        float lg = S[tt][rr]; bool ok = tok_ok[tt];
                        if (MODE == 0) { const bool latk = kr_[tt] >= 0; const int kc = kc0_[tt] + 4 * gq + rr; const bool inw = (unsigned)(kc - cs) < 16u; const int bi = (kr_[tt] - r + 7) * 31 + (kc - qc + 15); const float bv = srpb[bi];
                            lg += (latk && inw) ? bv : 0.f; ok = latk ? inw : true; }
                        if (MODE == 1) { if (kr_[tt] == 0) { const int kt = kc0_[tt] + 4 * gq + rr; const int dd = (tq * 16 + cq) - kt; ok = ok && ((unsigned)(dd + 128) <= 256u); } }
                        const float e = __builtin_amdgcn_exp2f(lg * 1.4426950408889634f - shift2);
                        p[tt][rr] = ok ? e : 0.f; lsum[j] += p[tt][rr];
                    }
                u32x4 pw; pw.x = pg8::cvt_pk_bf16(p[0][0], p[0][1]); pw.y = pg8::cvt_pk_bf16(p[0][2], p[0][3]); pw.z = pg8::cvt_pk_bf16(p[1][0], p[1][1]); pw.w = pg8::cvt_pk_bf16(p[1][2], p[1][3]);
                const bf16x8 pb = __builtin_bit_cast(bf16x8, pw);
#pragma unroll
                for (int dt = 0; dt < 4; ++dt) { u32x4 vw; vw.x = vf[dt][0].x; vw.y = vf[dt][0].y; vw.z = vf[dt][1].x; vw.w = vf[dt][1].y;
                    O[j][dt] = __builtin_amdgcn_mfma_f32_16x16x32_bf16(__builtin_bit_cast(bf16x8, vw), pb, O[j][dt], 0, 0, 0); }
            }
            if (j & 1) __builtin_amdgcn_sched_barrier(0);
        }
#pragma unroll
        for (int tt = 0; tt < 2; ++tt) { kf[tt][0] = kn[tt][0]; kf[tt][1] = kn[tt][1];
#if ATT_K2
            kn[tt][0] = k2[tt][0]; kn[tt][1] = k2[tt][1];
#endif
#pragma unroll
            for (int dt = 0; dt < 4; ++dt) vf[dt][tt] = vn[dt][tt]; }
    }
#pragma unroll
    for (int j = 0; j < 4; ++j) {
        float ls = lsum[j]; ls += xsw<16>(ls); ls += xsw<32>(ls);
        if (MODE == 1 || MODE == 3) ls += __builtin_amdgcn_exp2f(sinkp[h0 + j] * 1.4426950408889634f - shift2);
        const float inv = 1.f / ls; const int hh = NA ? hx_ : (h0 + j);
        bf16_t* op = outb + (size_t)(qrow[j] + c) * 4096 + hh * 64 + 4 * g;
#pragma unroll
        for (int dt = 0; dt < 4; ++dt) { u32x2 w; w.x = pg8::cvt_pk_bf16(O[j][dt][0] * inv, O[j][dt][1] * inv); w.y = pg8::cvt_pk_bf16(O[j][dt][2] * inv, O[j][dt][3] * inv); *(u32x2*)(op + dt * 16) = w; }
    }
}
typedef short s16x4 __attribute__((ext_vector_type(4)));
__device__ __forceinline__ void lds_barrier() { asm volatile("s_waitcnt lgkmcnt(0)" ::: "memory"); __builtin_amdgcn_s_barrier(); asm volatile("" ::: "memory"); }
constexpr int CH_QM = 0, CH_KM = 17408, CH_QS = 34816, CH_KS = 52224, CH_V = 69632, CH_AM = 78848, CH_S = 88064, CH_GC = 105472, CH_GL = 138240, CH_TOT = 142336, CH_CST = 144384, CH_CS = 145920;
constexpr int ST128 = 272, ST64 = 144;
__device__ __forceinline__ bf16x8 row_frag(LAS const unsigned char* t, int stride, int row, int kbyte) { return *(LAS const bf16x8*)(t + row * stride + kbyte); }
__device__ __forceinline__ bf16x8 tr_frag(LAS const unsigned char* t, int stride, int k0, int c0, int lane) {
    const int g = lane >> 4, i = lane & 15, q = i >> 2, p = i & 3;
    LAS const unsigned char* a = t + (k0 + 8 * g + q) * stride + (c0 + 4 * p) * 2;
    const s16x4 lo = __builtin_amdgcn_ds_read_tr16_b64_v4i16((LAS s16x4*)a), hi = __builtin_amdgcn_ds_read_tr16_b64_v4i16((LAS s16x4*)(a + 4 * stride));
    bf16x8 r; r[0] = lo[0]; r[1] = lo[1]; r[2] = lo[2]; r[3] = lo[3]; r[4] = hi[0]; r[5] = hi[1]; r[6] = hi[2]; r[7] = hi[3]; return r;
}
constexpr int CH_V2 = 122880, CH_S2 = 105472;
template <int KIND>
__device__ __forceinline__ void chain_mfma(Frame& F, int l, int b, int h, int dir, int vs) {
    constexpr int NV = (KIND == 1) ? 2 : 1;
    LAS unsigned char* L = F.lds;
    const int tid = F.tid, lane = F.lane, wave = F.wave, g = lane >> 4, i16 = lane & 15;
    const int cc = tid & 15, rg = tid >> 4;
    const int vrow = tid >> 3, vch = tid & 7;
    const bf16_t* xact = F.hn(); const bf16_t* p1 = F.p1();
    bf16_t* outp = (KIND == 0 ? F.ys() : F.og()) + (size_t)dir * MR * 1024;
    const int ocol = KIND == 0 ? h * 64 : h * 256 + vs * 128;
    float a_ssd = 0.f;
    if (KIND == 0) a_ssd = -expf(F.in[I_ALOG][l * 32 + dir * 16 + h]);

    f32x4 Sacc[NV][4];
#pragma unroll
    for (int sv = 0; sv < NV; ++sv)
#pragma unroll
        for (int v = 0; v < 4; ++v) Sacc[sv][v] = (f32x4){0.f, 0.f, 0.f, 0.f};
    __syncthreads();
    for (int e = tid; e < 17408 / 4; e += 512) { ((LAS unsigned*)(L + CH_S))[e] = 0u; if (NV == 2) ((LAS unsigned*)(L + CH_S2))[e] = 0u; }
    auto rowof = [&](int t) -> int { const bool lat = t >= LCTX; const int n = lat ? SEQ : LCTX, tt = lat ? t - LCTX : t, base = lat ? b * SEQ : RX + b * LCTX; return base + (dir ? (n - 1 - tt) : tt); };
    u32x4 rq[2], rk[2], rv, rv2 = (u32x4){0u, 0u, 0u, 0u}; float rg0 = 0.f, rcs0 = 0.f, rcs1 = 0.f, rcs63 = 0.f, rcsl = 0.f; f32x4 gq[2][2], gref[2], gend[2];
    auto prefetch = [&](int t0) {
#pragma unroll
        for (int j = 0; j < 2; ++j) { const size_t row = (size_t)rowof(t0 + rg + 32 * j);
            if (KIND == 0) { rq[j] = *(const u32x4*)(xact + row * 2048 + 1536 + (h >> 2) * 128 + cc * 8); rk[j] = *(const u32x4*)(xact + row * 2048 + 1024 + (h >> 2) * 128 + cc * 8); }
            else { rq[j] = *(const u32x4*)(p1 + row * P1W + C_GQ + h * 128 + cc * 8); rk[j] = *(const u32x4*)(p1 + row * P1W + C_GK + h * 128 + cc * 8);
                   const float* gp = F.gcum() + ((size_t)dir * MR + row) * 512 + h * 128 + cc * 8; gq[j][0] = *(const f32x4*)gp; gq[j][1] = *(const f32x4*)(gp + 4); } }
        if (KIND == 1) { const float* gr = F.gcum() + ((size_t)dir * MR + rowof(t0 + 31)) * 512 + h * 128 + cc * 8; const float* ge = F.gcum() + ((size_t)dir * MR + rowof(t0 + 63)) * 512 + h * 128 + cc * 8;
            gref[0] = *(const f32x4*)gr; gref[1] = *(const f32x4*)(gr + 4); gend[0] = *(const f32x4*)ge; gend[1] = *(const f32x4*)(ge + 4); }
        { const size_t row = (size_t)rowof(t0 + vrow);
            if (KIND == 0) { rv = *(const u32x4*)(xact + row * 2048 + h * 64 + vch * 8); rg0 = F.dt()[row * 32 + dir * 16 + h];
                const float* cp = F.csum() + (size_t)dir * MR * 16 + h;
                rcs0 = cp[(size_t)rowof(t0 + rg) * 16]; rcs1 = cp[(size_t)rowof(t0 + rg + 32) * 16]; rcs63 = cp[(size_t)rowof(t0 + 63) * 16]; rcsl = (tid < 64) ? cp[(size_t)rowof(t0 + tid) * 16] : 0.f; }
            else { rv = *(const u32x4*)(p1 + row * P1W + C_GV + h * 256 + vs * 128 + vch * 8); rv2 = *(const u32x4*)(p1 + row * P1W + C_GV + h * 256 + vs * 128 + 64 + vch * 8); } }
    };
    prefetch(0);
    LAS float* gcT = (LAS float*)(L + CH_GC); LAS float* glT = (LAS float*)(L + CH_GL); LAS float* totT = (LAS float*)(L + CH_TOT); LAS float* cstT = (LAS float*)(L + CH_CST); LAS float* csT = (LAS float*)(L + CH_CS);
#pragma unroll 1
    for (int t0 = 0; t0 < LCTX + SEQ; t0 += 64) {
        if (KIND == 0) { if (tid < 64) csT[tid] = rcsl; }
        float egr[8], eger[8];
        if (KIND == 1) {
#pragma unroll
            for (int e = 0; e < 8; ++e) { const float gr = gref[e >> 2][e & 3]; egr[e] = __expf(gr); eger[e] = __expf(gend[e >> 2][e & 3] - gr); } }
#pragma unroll
        for (int j = 0; j < 2; ++j) { const int lr = rg + 32 * j;
            float q8[8] = {lo2f(rq[j].x), hi2f(rq[j].x), lo2f(rq[j].y), hi2f(rq[j].y), lo2f(rq[j].z), hi2f(rq[j].z), lo2f(rq[j].w), hi2f(rq[j].w)};
            float k8[8] = {lo2f(rk[j].x), hi2f(rk[j].x), lo2f(rk[j].y), hi2f(rk[j].y), lo2f(rk[j].z), hi2f(rk[j].z), lo2f(rk[j].w), hi2f(rk[j].w)};
            float qm[8], km[8], qs[8], ks[8];
            if (KIND == 0) { const float csl = j ? rcs1 : rcs0; const float e1 = __expf(csl), e2 = __expf(rcs63 - csl);
#pragma unroll
                for (int e = 0; e < 8; ++e) { qm[e] = q8[e]; km[e] = k8[e]; qs[e] = q8[e] * e1; ks[e] = k8[e] * e2; } }
            else {
#pragma unroll
                for (int e = 0; e < 8; ++e) { const float gl = gq[j][e >> 2][e & 3], gr = gref[e >> 2][e & 3];
                    const float e1 = __expf(gl - gr), e2 = __builtin_amdgcn_rcpf(e1);
                    const float qq = q8[e] * 0.08838834764831845f; qm[e] = qq * e1; km[e] = k8[e] * e2; qs[e] = qm[e] * egr[e]; ks[e] = km[e] * eger[e]; } }
            u32x4 w;
            w.x = pack2(qm[0], qm[1]); w.y = pack2(qm[2], qm[3]); w.z = pack2(qm[4], qm[5]); w.w = pack2(qm[6], qm[7]); *(LAS u32x4*)(L + CH_QM + lr * ST128 + cc * 16) = w;
            w.x = pack2(km[0], km[1]); w.y = pack2(km[2], km[3]); w.z = pack2(km[4], km[5]); w.w = pack2(km[6], km[7]); *(LAS u32x4*)(L + CH_KM + lr * ST128 + cc * 16) = w;
            w.x = pack2(qs[0], qs[1]); w.y = pack2(qs[2], qs[3]); w.z = pack2(qs[4], qs[5]); w.w = pack2(qs[6], qs[7]); *(LAS u32x4*)(L + CH_QS + lr * ST128 + cc * 16) = w;
            w.x = pack2(ks[0], ks[1]); w.y = pack2(ks[2], ks[3]); w.z = pack2(ks[4], ks[5]); w.w = pack2(ks[6], ks[7]); *(LAS u32x4*)(L + CH_KS + lr * ST128 + cc * 16) = w; }
        if (KIND == 1) { if (rg == 0) {
#pragma unroll
                for (int e = 0; e < 8; ++e) cstT[256 + cc * 8 + e] = __expf(gend[e >> 2][e & 3]); } }
        { u32x4 w = rv;
            if (KIND == 0) { const float d = rg0;
                w.x = pack2(lo2f(rv.x) * d, hi2f(rv.x) * d); w.y = pack2(lo2f(rv.y) * d, hi2f(rv.y) * d); w.z = pack2(lo2f(rv.z) * d, hi2f(rv.z) * d); w.w = pack2(lo2f(rv.w) * d, hi2f(rv.w) * d); }
            *(LAS u32x4*)(L + CH_V + vrow * ST64 + vch * 16) = w; if (NV == 2) *(LAS u32x4*)(L + CH_V2 + vrow * ST64 + vch * 16) = rv2; }
        const float ds_ssd = (KIND == 0) ? __expf(rcs63) : 0.f;
        lds_barrier();
        float dS[4];
#pragma unroll
        for (int r = 0; r < 4; ++r) dS[r] = (KIND == 0) ? ds_ssd : cstT[256 + wave * 16 + 4 * g + r];
        if (t0 + 64 < LCTX + SEQ) prefetch(t0 + 64);
        for (int tix = wave; tix < 12; tix += 8) {
            int li, sj; if (tix == 0) { li = 0; sj = 0; } else if (tix < 3) { li = 1; sj = tix - 1; } else if (tix < 6) { li = 2; sj = tix - 3; } else if (tix < 10) { li = 3; sj = tix - 6; } else { li = (tix - 10) * 2; sj = li + 1; }
            f32x4 acc = (f32x4){0.f, 0.f, 0.f, 0.f};
            if (tix < 10) {
#pragma unroll
                for (int ks_ = 0; ks_ < 4; ++ks_) acc = __builtin_amdgcn_mfma_f32_16x16x32_bf16(row_frag(L + CH_KM, ST128, sj * 16 + i16, ks_ * 64 + g * 16), row_frag(L + CH_QM, ST128, li * 16 + i16, ks_ * 64 + g * 16), acc, 0, 0, 0);
                const int lrow = li * 16 + i16;
#pragma unroll
                for (int r = 0; r < 4; ++r) { const int s = sj * 16 + 4 * g + r; float v = acc[r];
                    if (KIND == 0) v *= __expf(fminf(csT[lrow] - csT[s], 0.f));
                    acc[r] = (s <= lrow) ? v : 0.f; } }
            u32x2 w; w.x = pack2(acc[0], acc[1]); w.y = pack2(acc[2], acc[3]);
            *(LAS u32x2*)(L + CH_AM + (li * 16 + i16) * ST64 + (sj * 16 + 4 * g) * 2) = w;
        }
        lds_barrier();
#pragma unroll
        for (int sv = 0; sv < NV; ++sv) { LAS unsigned char* Ss = L + (sv ? CH_S2 : CH_S); LAS unsigned char* Vs = L + (sv ? CH_V2 : CH_V);
#pragma unroll
        for (int tt = 0; tt < 2; ++tt) { const int tile = wave * 2 + tt, vi = tile >> 2, li = tile & 3;
            f32x4 acc = (f32x4){0.f, 0.f, 0.f, 0.f};
#pragma unroll
            for (int ks_ = 0; ks_ < 4; ++ks_) acc = __builtin_amdgcn_mfma_f32_16x16x32_bf16(row_frag(Ss, ST128, vi * 16 + i16, ks_ * 64 + g * 16), row_frag(L + CH_QS, ST128, li * 16 + i16, ks_ * 64 + g * 16), acc, 0, 0, 0);
            for (int kk = 0; kk <= (li >> 1); ++kk) acc = __builtin_amdgcn_mfma_f32_16x16x32_bf16(tr_frag(Vs, ST64, kk * 32, vi * 16, lane), row_frag(L + CH_AM, ST64, li * 16 + i16, kk * 64 + g * 16), acc, 0, 0, 0);
            const int lrow = li * 16 + i16; u32x2 w; w.x = pack2(acc[0], acc[1]); w.y = pack2(acc[2], acc[3]);
            *(u32x2*)(outp + (size_t)rowof(t0 + lrow) * 1024 + ocol + sv * 64 + vi * 16 + 4 * g) = w; } }
        { bf16x8 ka[2];
#pragma unroll
            for (int kk = 0; kk < 2; ++kk) ka[kk] = tr_frag(L + CH_KS, ST128, kk * 32, wave * 16, lane);
#pragma unroll
            for (int sv = 0; sv < NV; ++sv)
#pragma unroll
            for (int vi = 0; vi < 4; ++vi) {
#pragma unroll
                for (int r = 0; r < 4; ++r) Sacc[sv][vi][r] *= dS[r];
#pragma unroll
                for (int kk = 0; kk < 2; ++kk) Sacc[sv][vi] = __builtin_amdgcn_mfma_f32_16x16x32_bf16(ka[kk], tr_frag(L + (sv ? CH_V2 : CH_V), ST64, kk * 32, vi * 16, lane), Sacc[sv][vi], 0, 0, 0); } }
        lds_barrier();
#pragma unroll
        for (int sv = 0; sv < NV; ++sv)
#pragma unroll
        for (int vi = 0; vi < 4; ++vi) { u32x2 w; w.x = pack2(Sacc[sv][vi][0], Sacc[sv][vi][1]); w.y = pack2(Sacc[sv][vi][2], Sacc[sv][vi][3]);
            *(LAS u32x2*)(L + (sv ? CH_S2 : CH_S) + (vi * 16 + i16) * ST128 + (wave * 16 + 4 * g) * 2) = w; }
    }
    __syncthreads();
}

constexpr int C2_QM = 0, C2_KM = 17408, C2_S1 = 34816, C2_V1 = 52224, C2_W1 = 123904, C2_V0 = 69632, C2_AM0 = 78848, C2_S0 = 88064, C2_W0 = 105472, C2_AM1 = 114688, C2_CS = 145920;
__device__ __forceinline__ void chain_ssd2(Frame& F, int l, int b, int hp, int dir) {
    LAS unsigned char* L = F.lds;
    const int tid = F.tid, lane = F.lane, wave = F.wave, g = lane >> 4, i16 = lane & 15;
    const int cc = tid & 15, rg = tid >> 4, vrow = tid >> 3, vch = tid & 7;
    const bf16_t* xact = F.hn();
    bf16_t* outp = F.ys() + (size_t)dir * MR * 1024;
    const int h0 = hp * 2, grp = h0 >> 2;
    f32x4 Sacc[2][4];
#pragma unroll
    for (int hd = 0; hd < 2; ++hd)
#pragma unroll
        for (int v = 0; v < 4; ++v) Sacc[hd][v] = (f32x4){0.f, 0.f, 0.f, 0.f};
    __syncthreads();
    for (int e = tid; e < 17408 / 4; e += 512) { ((LAS unsigned*)(L + C2_S0))[e] = 0u; ((LAS unsigned*)(L + C2_S1))[e] = 0u; }
    auto rowof = [&](int t) -> int { const bool lat = t >= LCTX; const int n = lat ? SEQ : LCTX, tt = lat ? t - LCTX : t, base = lat ? b * SEQ : RX + b * LCTX; return base + (dir ? (n - 1 - tt) : tt); };
    u32x4 rq[2], rk[2], rv[2]; float rdt[2], rcsv[2], rcs63[2], rcsl[2];
    auto prefetch = [&](int t0) {
#pragma unroll
        for (int j = 0; j < 2; ++j) { const size_t row = (size_t)rowof(t0 + rg + 32 * j);
            rq[j] = *(const u32x4*)(xact + row * 2048 + 1536 + grp * 128 + cc * 8); rk[j] = *(const u32x4*)(xact + row * 2048 + 1024 + grp * 128 + cc * 8); }
        const size_t vr = (size_t)rowof(t0 + vrow), r63 = (size_t)rowof(t0 + 63), rl = (size_t)rowof(t0 + (tid & 63));
#pragma unroll
        for (int hd = 0; hd < 2; ++hd) { const int h = h0 + hd; const float* cp = F.csum() + (size_t)dir * MR * 16 + h;
            rv[hd] = *(const u32x4*)(xact + vr * 2048 + h * 64 + vch * 8); rdt[hd] = F.dt()[vr * 32 + dir * 16 + h];
            rcsv[hd] = cp[vr * 16]; rcs63[hd] = cp[r63 * 16]; rcsl[hd] = cp[rl * 16]; }
    };
    prefetch(0);
    LAS float* csT = (LAS float*)(L + C2_CS);
#pragma unroll 1
    for (int t0 = 0; t0 < LCTX + SEQ; t0 += 64) {
        if (tid < 128) csT[tid] = (tid < 64) ? rcsl[0] : rcsl[1];
#pragma unroll
        for (int j = 0; j < 2; ++j) { const int lr = rg + 32 * j; *(LAS u32x4*)(L + C2_QM + lr * ST128 + cc * 16) = rq[j]; *(LAS u32x4*)(L + C2_KM + lr * ST128 + cc * 16) = rk[j]; }
        float dSh[2];
#pragma unroll
        for (int hd = 0; hd < 2; ++hd) { const float d = rdt[hd], e2 = __expf(rcs63[hd] - rcsv[hd]); const u32x4 x = rv[hd]; u32x4 w, w2;
            const float f0 = lo2f(x.x) * d, f1 = hi2f(x.x) * d, f2 = lo2f(x.y) * d, f3 = hi2f(x.y) * d, f4 = lo2f(x.z) * d, f5 = hi2f(x.z) * d, f6 = lo2f(x.w) * d, f7 = hi2f(x.w) * d;
            w.x = pack2(f0, f1); w.y = pack2(f2, f3); w.z = pack2(f4, f5); w.w = pack2(f6, f7);
            w2.x = pack2(f0 * e2, f1 * e2); w2.y = pack2(f2 * e2, f3 * e2); w2.z = pack2(f4 * e2, f5 * e2); w2.w = pack2(f6 * e2, f7 * e2);
            *(LAS u32x4*)(L + (hd ? C2_V1 : C2_V0) + vrow * ST64 + vch * 16) = w; *(LAS u32x4*)(L + (hd ? C2_W1 : C2_W0) + vrow * ST64 + vch * 16) = w2;
            dSh[hd] = __expf(rcs63[hd]); }
        lds_barrier();
        if (t0 + 64 < LCTX + SEQ) prefetch(t0 + 64);
        for (int tix = wave; tix < 12; tix += 8) {
            int li, sj; if (tix == 0) { li = 0; sj = 0; } else if (tix < 3) { li = 1; sj = tix - 1; } else if (tix < 6) { li = 2; sj = tix - 3; } else if (tix < 10) { li = 3; sj = tix - 6; } else { li = (tix - 10) * 2; sj = li + 1; }
            f32x4 acc = (f32x4){0.f, 0.f, 0.f, 0.f};
            if (tix < 10) {
#pragma unroll
                for (int ks_ = 0; ks_ < 4; ++ks_) acc = __builtin_amdgcn_mfma_f32_16x16x32_bf16(row_frag(L + C2_KM, ST128, sj * 16 + i16, ks_ * 64 + g * 16), row_frag(L + C2_QM, ST128, li * 16 + i16, ks_ * 64 + g * 16), acc, 0, 0, 0); }
            const int lrow = li * 16 + i16;
#pragma unroll
            for (int hd = 0; hd < 2; ++hd) { f32x4 a2 = (f32x4){0.f, 0.f, 0.f, 0.f};
                if (tix < 10) {
#pragma unroll
                    for (int r = 0; r < 4; ++r) { const int s = sj * 16 + 4 * g + r; const float v = acc[r] * __expf(fminf(csT[hd * 64 + lrow] - csT[hd * 64 + s], 0.f)); a2[r] = (s <= lrow) ? v : 0.f; } }
                u32x2 w; w.x = pack2(a2[0], a2[1]); w.y = pack2(a2[2], a2[3]);
                *(LAS u32x2*)(L + (hd ? C2_AM1 : C2_AM0) + lrow * ST64 + (sj * 16 + 4 * g) * 2) = w; }
        }
        lds_barrier();
#pragma unroll
        for (int hd = 0; hd < 2; ++hd) { LAS unsigned char* Ss = L + (hd ? C2_S1 : C2_S0); LAS unsigned char* Vs = L + (hd ? C2_V1 : C2_V0); LAS unsigned char* As = L + (hd ? C2_AM1 : C2_AM0);
#pragma unroll
            for (int tt = 0; tt < 2; ++tt) { const int tile = wave * 2 + tt, vi = tile >> 2, li = tile & 3, lrow = li * 16 + i16;
                f32x4 acc = (f32x4){0.f, 0.f, 0.f, 0.f};
#pragma unroll
                for (int ks_ = 0; ks_ < 4; ++ks_) acc = __builtin_amdgcn_mfma_f32_16x16x32_bf16(row_frag(Ss, ST128, vi * 16 + i16, ks_ * 64 + g * 16), row_frag(L + C2_QM, ST128, lrow, ks_ * 64 + g * 16), acc, 0, 0, 0);
                const float e1 = __expf(csT[hd * 64 + lrow]);
                acc *= e1;
                for (int kk = 0; kk <= (li >> 1); ++kk) acc = __builtin_amdgcn_mfma_f32_16x16x32_bf16(tr_frag(Vs, ST64, kk * 32, vi * 16, lane), row_frag(As, ST64, lrow, kk * 64 + g * 16), acc, 0, 0, 0);
                u32x2 w; w.x = pack2(acc[0], acc[1]); w.y = pack2(acc[2], acc[3]);
                *(u32x2*)(outp + (size_t)rowof(t0 + lrow) * 1024 + (h0 + hd) * 64 + vi * 16 + 4 * g) = w; } }
        { bf16x8 ka[2];
#pragma unroll
            for (int kk = 0; kk < 2; ++kk) ka[kk] = tr_frag(L + C2_KM, ST128, kk * 32, wave * 16, lane);
#pragma unroll
            for (int hd = 0; hd < 2; ++hd)
#pragma unroll
                for (int vi = 0; vi < 4; ++vi) { Sacc[hd][vi] *= dSh[hd];
#pragma unroll
                    for (int kk = 0; kk < 2; ++kk) Sacc[hd][vi] = __builtin_amdgcn_mfma_f32_16x16x32_bf16(ka[kk], tr_frag(L + (hd ? C2_W1 : C2_W0), ST64, kk * 32, vi * 16, lane), Sacc[hd][vi], 0, 0, 0); } }
        lds_barrier();
#pragma unroll
        for (int hd = 0; hd < 2; ++hd)
#pragma unroll
            for (int vi = 0; vi < 4; ++vi) { u32x2 w; w.x = pack2(Sacc[hd][vi][0], Sacc[hd][vi][1]); w.y = pack2(Sacc[hd][vi][2], Sacc[hd][vi][3]);
                *(LAS u32x2*)(L + (hd ? C2_S1 : C2_S0) + (vi * 16 + i16) * ST128 + (wave * 16 + 4 * g) * 2) = w; }
    }
    __syncthreads();
}
__device__ __forceinline__ void ssd_chain(Frame& F, int l, int b, int h, int dir) {
    const bf16_t* xact = F.hn();
    const float a = -expf(F.in[I_ALOG][l * 32 + dir * 16 + h]);
    const int p = F.tid >> 3, nq = F.tid & 7, grp = h >> 2;
    bf16_t* sx = (bf16_t*)F.ldsg;
    bf16_t* sB = (bf16_t*)(F.ldsg + 4096);
    bf16_t* sC = (bf16_t*)(F.ldsg + 4096 + 8192);
    float* sdt = (float*)(F.ldsg + 20480);
    float* sy = (float*)(F.ldsg + 20480 + 128);
    bf16_t* yout = F.ys() + (size_t)dir * MR * 1024;
    float st[16];
#pragma unroll
    for (int i = 0; i < 16; ++i) st[i] = 0.f;
    for (int seg = 0; seg < 2; ++seg) {
        const int n = seg ? SEQ : LCTX, base = seg ? b * SEQ : RX + b * LCTX;
        for (int blk = 0; blk < n; blk += 32) {
            __syncthreads();
            for (int e = F.tid; e < 1280; e += 512) {
                int i, off, ldsoff;
                if (e < 256) { i = e >> 3; off = h * 64 + (e & 7) * 8; ldsoff = i * 128 + (e & 7) * 16; }
                else if (e < 768) { const int f = e - 256; i = f >> 4; off = 1024 + grp * 128 + (f & 15) * 8; ldsoff = 4096 + i * 256 + (f & 15) * 16; }
                else { const int f = e - 768; i = f >> 4; off = 1536 + grp * 128 + (f & 15) * 8; ldsoff = 4096 + 8192 + i * 256 + (f & 15) * 16; }
                const int ps = dir ? (n - 1 - (blk + i)) : (blk + i);
                *(u32x4*)(F.ldsg + ldsoff) = *(const u32x4*)(xact + (size_t)(base + ps) * 2048 + off);
            }
            if (F.tid < 32) { const int ps = dir ? (n - 1 - (blk + F.tid)) : (blk + F.tid); sdt[F.tid] = F.dt()[(size_t)(base + ps) * 32 + dir * 16 + h]; }
            __syncthreads();
            for (int i = 0; i < 32; ++i) {
                const float dtv = sdt[i], dec = __expf(dtv * a), xv = bf2f(sx[i * 64 + p]) * dtv;
                const u32x4 b0 = *(const u32x4*)(sB + i * 128 + nq * 16), b1 = *(const u32x4*)(sB + i * 128 + nq * 16 + 8);
                const u32x4 c0 = *(const u32x4*)(sC + i * 128 + nq * 16), c1 = *(const u32x4*)(sC + i * 128 + nq * 16 + 8);
                const float Bv[16] = {lo2f(b0.x), hi2f(b0.x), lo2f(b0.y), hi2f(b0.y), lo2f(b0.z), hi2f(b0.z), lo2f(b0.w), hi2f(b0.w), lo2f(b1.x), hi2f(b1.x), lo2f(b1.y), hi2f(b1.y), lo2f(b1.z), hi2f(b1.z), lo2f(b1.w), hi2f(b1.w)};
                const float Cv[16] = {lo2f(c0.x), hi2f(c0.x), lo2f(c0.y), hi2f(c0.y), lo2f(c0.z), hi2f(c0.z), lo2f(c0.w), hi2f(c0.w), lo2f(c1.x), hi2f(c1.x), lo2f(c1.y), hi2f(c1.y), lo2f(c1.z), hi2f(c1.z), lo2f(c1.w), hi2f(c1.w)};
                float yp = 0.f;
#pragma unroll
                for (int q = 0; q < 16; ++q) { st[q] = dec * st[q] + xv * Bv[q]; yp += Cv[q] * st[q]; }
                yp += xsw<1>(yp); yp += xsw<2>(yp); yp += xsw<4>(yp);
                if (nq == 0) sy[i * 64 + p] = yp;
            }
            __syncthreads();
            { const int i = F.tid >> 4, p4 = (F.tid & 15) * 4; const int ps = dir ? (n - 1 - (blk + i)) : (blk + i);
              u32x2 w; w.x = pack2(sy[i * 64 + p4], sy[i * 64 + p4 + 1]); w.y = pack2(sy[i * 64 + p4 + 2], sy[i * 64 + p4 + 3]);
              *(u32x2*)(yout + (size_t)(base + ps) * 1024 + h * 64 + p4) = w; }
        }
    }
}

__device__ __forceinline__ void gla_chain(Frame& F, int l, int b, int h, int dir, int vs) {
    const int vv = F.tid & 63, kg = F.tid >> 6;
    float* sq = (float*)F.ldsg;
    float* sk = sq + 2048;
    float* se = sk + 2048;
    float* sv = se + 2048;
    float* swg = sv + 1024;
    float* sbg = swg + 2048;
    float* sgl = sbg + 128;
    float* sop = sgl + 256;
    bf16_t* oout = F.og() + (size_t)dir * MR * 1024;
    __syncthreads();
    for (int e = F.tid; e < 2048; e += 512) { const int r = e >> 7, c = e & 127; swg[e] = F.in[I_GLAWG][(((size_t)l * 2 + dir) * 16 + r) * 512 + h * 128 + c]; }
    if (F.tid < 128) sbg[F.tid] = F.in[I_GLABG][((size_t)l * 2 + dir) * 512 + h * 128 + F.tid];
    float st[16];
#pragma unroll
    for (int i = 0; i < 16; ++i) st[i] = 0.f;
    for (int seg = 0; seg < 2; ++seg) {
        const int n = seg ? SEQ : LCTX, base = seg ? b * SEQ : RX + b * LCTX;
        for (int blk = 0; blk < n; blk += 16) {
            __syncthreads();
            if (F.tid < 256) { const int i = F.tid >> 4, r = F.tid & 15; const int ps = dir ? (n - 1 - (blk + i)) : (blk + i); sgl[F.tid] = F.glr()[(size_t)(base + ps) * 32 + dir * 16 + r]; }
            for (int e = F.tid; e < 2048; e += 512) { const int i = e >> 7, c = e & 127; const int ps = dir ? (n - 1 - (blk + i)) : (blk + i); const bf16_t* rp = F.p1() + (size_t)(base + ps) * P1W;
                sq[e] = bf2f(rp[C_GQ + h * 128 + c]) * 0.08838834764831845f; sk[e] = bf2f(rp[C_GK + h * 128 + c]); }
            for (int e = F.tid; e < 1024; e += 512) { const int i = e >> 6, c = e & 63; const int ps = dir ? (n - 1 - (blk + i)) : (blk + i); sv[e] = bf2f(F.p1()[(size_t)(base + ps) * P1W + C_GV + h * 256 + vs * 64 + c]); }
            __syncthreads();
            for (int e = F.tid; e < 2048; e += 512) { const int i = e >> 7, c = e & 127; float lg = sbg[c];
#pragma unroll
                for (int r = 0; r < 16; ++r) lg += sgl[i * 16 + r] * swg[r * 128 + c];
                const float ls = fminf(lg, 0.f) - log1pf(__expf(-fabsf(lg)));
                se[e] = __expf(ls * (1.f / 16.f)); }
            __syncthreads();
            for (int i = 0; i < 16; ++i) {
                const float vval = sv[i * 64 + vv]; float o = 0.f;
#pragma unroll
                for (int q4 = 0; q4 < 4; ++q4) { const f32x4 e4 = *(const f32x4*)(se + i * 128 + kg * 16 + q4 * 4), k4 = *(const f32x4*)(sk + i * 128 + kg * 16 + q4 * 4), qq = *(const f32x4*)(sq + i * 128 + kg * 16 + q4 * 4);
#pragma unroll
                    for (int j = 0; j < 4; ++j) { st[q4 * 4 + j] = e4[j] * st[q4 * 4 + j] + k4[j] * vval; o += qq[j] * st[q4 * 4 + j]; } }
                sop[(i * 8 + kg) * 64 + vv] = o;
            }
            __syncthreads();
            for (int e = F.tid; e < 1024; e += 512) { const int i = e >> 6, c = e & 63; float s = 0.f;
#pragma unroll
                for (int q = 0; q < 8; ++q) s += sop[(i * 8 + q) * 64 + c];
                const int ps = dir ? (n - 1 - (blk + i)) : (blk + i);
                oout[(size_t)(base + ps) * 1024 + h * 256 + vs * 64 + c] = f2bf(s); }
        }
    }
}

template <int NSLOT, class KF>
__device__ __forceinline__ void wave_attn(const bf16_t* qp, int nkeys, const KF& kf, bool has_sink, float sink, bf16_t* outp, int lane) {
    bf8_t q[8];
#pragma unroll
    for (int i = 0; i < 8; ++i) q[i] = *(const bf8_t*)(qp + i * 8);
    float lg[NSLOT]; float m = has_sink ? sink : -1e30f;
#pragma unroll
    for (int s = 0; s < NSLOT; ++s) {
        const int i = s * 64 + lane; float v = -1e30f;
        if (i < nkeys) { const bf16_t* kp; const bf16_t* vp; float bias;
            if (kf.key(i, kp, vp, bias)) { float d = 0.f;
#pragma unroll
                for (int c = 0; c < 8; ++c) { const bf8_t kw = *(const bf8_t*)(kp + c * 8);
                    d = __builtin_amdgcn_fdot2_f32_bf16(__builtin_shufflevector(q[c], q[c], 0, 1), __builtin_shufflevector(kw, kw, 0, 1), d, false);
                    d = __builtin_amdgcn_fdot2_f32_bf16(__builtin_shufflevector(q[c], q[c], 2, 3), __builtin_shufflevector(kw, kw, 2, 3), d, false);
                    d = __builtin_amdgcn_fdot2_f32_bf16(__builtin_shufflevector(q[c], q[c], 4, 5), __builtin_shufflevector(kw, kw, 4, 5), d, false);
                    d = __builtin_amdgcn_fdot2_f32_bf16(__builtin_shufflevector(q[c], q[c], 6, 7), __builtin_shufflevector(kw, kw, 6, 7), d, false); }
                v = d + bias; } }
        lg[s] = v; m = fmaxf(m, v);
    }
    m = wmax(m);
    float sum = 0.f;
#pragma unroll
    for (int s = 0; s < NSLOT; ++s) { const float p = (lg[s] > -1e29f) ? __expf(lg[s] - m) : 0.f; lg[s] = p; sum += p; }
    sum = wsum(sum); if (has_sink) sum += __expf(sink - m);
    float acc = 0.f;
#pragma unroll
    for (int s = 0; s < NSLOT; ++s) {
        const int cnt = (nkeys - s * 64) < 64 ? (nkeys - s * 64) : 64;
        for (int j = 0; j < cnt; ++j) { const float pj = rlane(lg[s], j);
            if (pj != 0.f) { const bf16_t* kp; const bf16_t* vp; float bias; kf.key(s * 64 + j, kp, vp, bias); acc += pj * bf2f(vp[lane]); } }
    }
    outp[lane] = f2bf(acc / sum);
}
struct KfNA { const bf16_t* p1; const float* rpb; int b, r, col, r0, c0, h;
    __device__ __forceinline__ bool key(int i, const bf16_t*& kp, const bf16_t*& vp, float& bias) const {
        if (i < 128) { const int kr = r0 + (i >> 4), kc = c0 + (i & 15); const bf16_t* rp = p1 + (size_t)(b * SEQ + kr * 64 + kc) * P1W + C_NA + h * 64;
            kp = rp + 1024; vp = rp + 2048; bias = rpb[(kr - r + 7) * 31 + (kc - col + 15)]; }
        else { const bf16_t* rp = p1 + (size_t)(RX + b * LCTX + (i - 128)) * P1W + C_NA + h * 64; kp = rp + 1024; vp = rp + 2048; bias = 0.f; }
        return true; } };
struct KfSWA { const bf16_t* p1; int b, lo, nloc, hk;
    __device__ __forceinline__ bool key(int i, const bf16_t*& kp, const bf16_t*& vp, float& bias) const {
        const int row = (i < nloc) ? (b * SEQ + lo + i) : (RX + b * LCTX + (i - nloc)); const bf16_t* rp = p1 + (size_t)row * P1W;
        kp = rp + C_SK + hk * 64; vp = rp + C_SV + hk * 64; bias = 0.f; return true; } };
struct KfCtxNA { const bf16_t* p1; int b, h;
    __device__ __forceinline__ bool key(int i, const bf16_t*& kp, const bf16_t*& vp, float& bias) const {
        const bf16_t* rp = p1 + (size_t)(RX + b * LCTX + i) * P1W + C_NA + h * 64; kp = rp + 1024; vp = rp + 2048; bias = 0.f; return true; } };

#ifndef ATTN_TASK
#define ATTN_TASK attn_task6
#endif
__device__ __forceinline__ void phase_mix(Frame& F, int l, int qslot, int only = 0) {
    const bool need_ctx = (l == 0);
    const int nU = 128 + 256 + 256 + (need_ctx ? 32 : 0);
    bf16_t* bout = F.outs() + 1 * 1024; bf16_t* dout = F.outs() + 3 * 1024;
    float* srpb = (float*)(F.ldsg + 98304);
    float rmax = 0.f;
    for (int e = F.tid; e < 16 * 465; e += 512) { const float v = F.in[I_RPB][(size_t)l * 16 * 465 + e]; srpb[e] = v; rmax = fmaxf(rmax, fabsf(v)); }
    bool rpb_ok = true;
    const float gq = wmax(fabsf(F.in[I_NAQN][l * 64 + F.lane])), gk = wmax(fabsf(F.in[I_NAKN][l * 64 + F.lane]));
    const float sq = wmax(fabsf(F.in[I_SWAQN][l * 64 + F.lane])), sk = wmax(fabsf(F.in[I_SWAKN][l * 64 + F.lane]));
    const float smx = wmax(F.lane < 16 ? F.in[I_SINK][l * 16 + F.lane] : -1e30f);
    rmax = wmax(rmax);
    float* sred = (float*)(F.ldsg + 128064);
    if (F.lane == 0) sred[F.wave] = rmax;
    __syncthreads();
    float rall = 0.f;
#pragma unroll
    for (int w = 0; w < 8; ++w) rall = fmaxf(rall, sred[w]);
    const float L2E = 1.4426950408889634f;
    const float shift_na = (8.2f * gq * gk + rall) * L2E, shift_sw = fmaxf(8.2f * sq * sk, smx) * L2E;
    const int qa = 200 + qslot * 4;
    for (;;) {
        const int u = next_unit(F, qslot);
        if (u >= 128) break;
        F.refresh(F.ws0);
        if (only >= 2) continue;
        if (u < 64) chain_mfma<1>(F, l, u >> 4, (u >> 2) & 3, (u >> 1) & 1, u & 1);
        else { const int v = u - 64; chain_ssd2(F, l, v >> 4, (v >> 1) & 7, v & 1); }
        rpb_ok = false;
    }
    if (!rpb_ok) { __syncthreads(); for (int e = F.tid; e < 16 * 465; e += 512) srpb[e] = F.in[I_RPB][(size_t)l * 16 * 465 + e]; __syncthreads(); rpb_ok = true; }
    for (;;) {
        const int v = next_unit(F, qa + 0);
        if (v >= 512) break;
        F.refresh(F.ws0);
        if (only == 1 || only == 4) continue;
        const int b = v >> 7, h = (v >> 3) & 15, rb = v & 7;
        attn_task4<0>(F, l, b, h, rb * 8 + F.wave, srpb + h * 465, shift_na, nullptr, bout, F.lane);
    }
    for (;;) {
        const int v = next_unit(F, qa + 1);
        if (v >= 512) break;
        F.refresh(F.ws0);
        if (only == 1 || only == 3) continue;
        const int b = v >> 7, kvh = (v >> 5) & 3, tb = v & 31;
        attn_task4<1>(F, l, b, kvh, tb * 8 + F.wave, srpb, shift_sw, F.in[I_SINK] + l * 16, dout, F.lane);
    }
    if (need_ctx) for (;;) {
        const int v = next_unit(F, qa + 2);
        if (v >= 32) break;
        F.refresh(F.ws0);
        if (only == 1 || only >= 3) continue;
        const int swa = v >> 4, b = (v >> 2) & 3, qd = v & 3;
#pragma unroll 1
        for (int t = F.wave; t < 16; t += 8) {
            if (!swa) attn_task4<2>(F, l, b, t, qd, srpb, shift_na, nullptr, bout, F.lane);
            else attn_task4<3>(F, l, b, t >> 2, qd * 4 + (t & 3), srpb, shift_sw, F.in[I_SINK] + l * 16, dout, F.lane); }
    }
}

__device__ __forceinline__ void phase_fin(Frame& F, int l, int nrows) {
    const bf16_t* xact = F.hn(); const bf16_t* yf = F.ys(); const bf16_t* yb = F.ys() + (size_t)MR * 1024; const bf16_t* of = F.og(); const bf16_t* ob = F.og() + (size_t)MR * 1024;
    bf16_t* aout = F.outs(); bf16_t* cout = F.outs() + 2 * 1024;
    for (int row = F.bid * 8 + F.wave; row < nrows; row += F.G * 8) {
        float y[16]; float ss = 0.f;
#pragma unroll
        for (int j = 0; j < 4; ++j) { const int c = j * 256 + F.lane * 4; const float dsk = F.in[I_SSDD][l * 16 + (c >> 6)];
            const u32x2 a = *(const u32x2*)(yf + (size_t)row * 1024 + c), bq = *(const u32x2*)(yb + (size_t)row * 1024 + c), xs = *(const u32x2*)(xact + (size_t)row * 2048 + c), z = *(const u32x2*)(F.p1() + (size_t)row * P1W + C_Z + c);
            y[j * 4 + 0] = (lo2f(a.x) + lo2f(bq.x) + dsk * lo2f(xs.x)) * siluf(lo2f(z.x)); y[j * 4 + 1] = (hi2f(a.x) + hi2f(bq.x) + dsk * hi2f(xs.x)) * siluf(hi2f(z.x));
            y[j * 4 + 2] = (lo2f(a.y) + lo2f(bq.y) + dsk * lo2f(xs.y)) * siluf(lo2f(z.y)); y[j * 4 + 3] = (hi2f(a.y) + hi2f(bq.y) + dsk * hi2f(xs.y)) * siluf(hi2f(z.y));
#pragma unroll
            for (int e = 0; e < 4; ++e) ss += y[j * 4 + e] * y[j * 4 + e]; }
        ss = wsum(ss); const float r = rsqrtf(ss * (1.f / 1024.f) + EPS);
#pragma unroll
        for (int j = 0; j < 4; ++j) { const int c = j * 256 + F.lane * 4; const f32x4 g = *(const f32x4*)(F.in[I_SSDNG] + (size_t)l * 1024 + c);
            u32x2 w; w.x = pack2(y[j * 4] * r * g[0], y[j * 4 + 1] * r * g[1]); w.y = pack2(y[j * 4 + 2] * r * g[2], y[j * 4 + 3] * r * g[3]); *(u32x2*)(aout + (size_t)row * 4096 + c) = w; }
#pragma unroll
        for (int j = 0; j < 4; ++j) { const int c = j * 256 + F.lane * 4;
            const u32x2 a = *(const u32x2*)(of + (size_t)row * 1024 + c), bq = *(const u32x2*)(ob + (size_t)row * 1024 + c), rr = *(const u32x2*)(F.p1() + (size_t)row * P1W + C_GR + c);
            const float o0 = lo2f(a.x) + lo2f(bq.x), o1 = hi2f(a.x) + hi2f(bq.x), o2 = lo2f(a.y) + lo2f(bq.y), o3 = hi2f(a.y) + hi2f(bq.y);
            float s2 = o0 * o0 + o1 * o1 + o2 * o2 + o3 * o3; s2 = wsum(s2); const float rn = rsqrtf(s2 * (1.f / 256.f) + EPS);
            const f32x4 g = *(const f32x4*)(F.in[I_GLANG] + (size_t)l * 256 + F.lane * 4);
            u32x2 w; w.x = pack2(o0 * rn * g[0] * siluf(lo2f(rr.x)), o1 * rn * g[1] * siluf(hi2f(rr.x))); w.y = pack2(o2 * rn * g[2] * siluf(lo2f(rr.y)), o3 * rn * g[3] * siluf(hi2f(rr.y)));
            *(u32x2*)(cout + (size_t)row * 4096 + c) = w; }
    }
}

template <int MODE>
__device__ __forceinline__ void ctx_gemm(Frame& F, int l, const float* ci, const float* modl) {
    constexpr int K = (MODE == 0) ? 4096 : 2048, NT = K / 64, SA = 0, SB = 2 * 128 * 144;
    LAS unsigned char* L = F.lds;
    const int tid = F.tid, lane = F.lane, wave = F.wave, g = lane >> 4, i16 = lane & 15, wm = wave >> 1, wn = wave & 1;
    const bf16_t* A = (MODE == 0) ? F.outs() : (MODE == 1) ? F.mb() : F.hn();
    const bf16_t* Bt = (MODE == 0) ? F.wbr() : (MODE == 1) ? F.wout() : F.wq();
    const int lr = tid >> 3, lc = (tid & 7) * 8;
    for (int u = F.bid; u < 256; u += F.G) {
        const int mt = u >> 5, nt = u & 31, row0 = RX + mt * 128, col0 = nt * 64;
        const bf16_t* ap = A + (size_t)(row0 + lr) * K + lc; const bf16_t* bp = Bt + (size_t)(col0 + lr) * K + lc;
        constexpr int RD = 8;
        u32x4 ra0[RD], ra1[RD], rb[RD];
#pragma unroll
        for (int j = 0; j < RD; ++j) { ra0[j] = *(const u32x4*)(ap + j * 64); ra1[j] = *(const u32x4*)(ap + (size_t)64 * K + j * 64); rb[j] = *(const u32x4*)(bp + j * 64); }
        f32x4 acc[2][2], tot[2][2];
#pragma unroll
        for (int mi = 0; mi < 2; ++mi)
#pragma unroll
            for (int ni = 0; ni < 2; ++ni) { acc[mi][ni] = (f32x4){0.f, 0.f, 0.f, 0.f}; tot[mi][ni] = (f32x4){0.f, 0.f, 0.f, 0.f}; }
        __syncthreads();
#pragma unroll 1
        for (int t0 = 0; t0 < NT; t0 += RD) {
#pragma unroll
          for (int j = 0; j < RD; ++j) { const int t = t0 + j;
            LAS unsigned char* as = L + SA + (j & 1) * 128 * 144; LAS unsigned char* bs = L + SB + (j & 1) * 64 * 144;
            *(LAS u32x4*)(as + lr * 144 + lc * 2) = ra0[j]; *(LAS u32x4*)(as + (lr + 64) * 144 + lc * 2) = ra1[j]; *(LAS u32x4*)(bs + lr * 144 + lc * 2) = rb[j];
            if (t + RD < NT) { ra0[j] = *(const u32x4*)(ap + (t + RD) * 64); ra1[j] = *(const u32x4*)(ap + (size_t)64 * K + (t + RD) * 64); rb[j] = *(const u32x4*)(bp + (t + RD) * 64); }
            lds_barrier();
#pragma unroll
            for (int kk = 0; kk < 2; ++kk) { bf16x8 af[2], bfr[2];
#pragma unroll
                for (int mi = 0; mi < 2; ++mi) af[mi] = row_frag(as, 144, wm * 32 + mi * 16 + i16, kk * 64 + g * 16);
#pragma unroll
                for (int ni = 0; ni < 2; ++ni) bfr[ni] = row_frag(bs, 144, wn * 32 + ni * 16 + i16, kk * 64 + g * 16);
#pragma unroll
                for (int mi = 0; mi < 2; ++mi)
#pragma unroll
                    for (int ni = 0; ni < 2; ++ni) acc[mi][ni] = __builtin_amdgcn_mfma_f32_16x16x32_bf16(bfr[ni], af[mi], acc[mi][ni], 0, 0, 0); }
            if (MODE == 0) { if ((t & 15) == 15) { const int br = t >> 4;
#pragma unroll
                for (int mi = 0; mi < 2; ++mi)
#pragma unroll
                    for (int ni = 0; ni < 2; ++ni) { const int row = row0 + wm * 32 + mi * 16 + i16, col = col0 + wn * 32 + ni * 16 + 4 * g;
                        const int ri = row & 255, ci_ = col & 255;
                        const unsigned gw = *(const unsigned*)((const unsigned char*)F.g() + pg8::gate_frag((row >> 8) * 32 + br * 8 + (col >> 8), ri >> 7, (ri & 63) >> 4, ci_ >> 7, ((ri & 127) >> 6) * 4 + ((ci_ & 127) >> 5), ((ci_ & 31) >> 3) * 16 + (ri & 15)) + (ci_ & 7));
#pragma unroll
                        for (int j = 0; j < 4; ++j) tot[mi][ni][j] += (float)((gw >> (8 * j)) & 255u) * (1.f / 255.f) * acc[mi][ni][j];
                        acc[mi][ni] = (f32x4){0.f, 0.f, 0.f, 0.f}; } } }
          }
        }
#pragma unroll
        for (int mi = 0; mi < 2; ++mi)
#pragma unroll
            for (int ni = 0; ni < 2; ++ni) { const int row = row0 + wm * 32 + mi * 16 + i16, col = col0 + wn * 32 + ni * 16 + 4 * g;
                if (MODE == 0) { u32x2 w; w.x = pg8::cvt_pk_bf16(tot[mi][ni][0], tot[mi][ni][1]); w.y = pg8::cvt_pk_bf16(tot[mi][ni][2], tot[mi][ni][3]); *(u32x2*)(F.mb() + (size_t)row * DM + col) = w; }
                else if (MODE == 1) { const f32x4 gt = *(const f32x4*)(modl + ((size_t)4 * 6 + 2) * DM + col); const f32x4 v = gt * acc[mi][ni];
                    u32x2 w; w.x = pg8::cvt_pk_bf16(v[0], v[1]); w.y = pg8::cvt_pk_bf16(v[2], v[3]); *(u32x2*)(F.ys() + (size_t)row * DM + col) = w; }
                else { u32x2 w; w.x = pg8::cvt_pk_bf16(acc[mi][ni][0], acc[mi][ni][1]); w.y = pg8::cvt_pk_bf16(acc[mi][ni][2], acc[mi][ni][3]); *(u32x2*)((bf16_t*)F.qp() + (size_t)row * DM + col) = w; } }
    }
    __syncthreads();
}
__device__ __forceinline__ unsigned ford(float f) { const unsigned u = __float_as_uint(f); return (u & 0x80000000u) ? ~u : (u | 0x80000000u); }
__device__ __forceinline__ float funord(unsigned k) { const unsigned u = (k & 0x80000000u) ? (k & 0x7fffffffu) : ~k; return __uint_as_float(u); }
__device__ __forceinline__ void phase_topk_search(Frame& F, int l, int nrows) {
    bf16_t* k1b = (bf16_t*)F.ldsg;
    bf16_t* k2b = k1b + 128 * 136;
    float* cval = (float*)(F.ldsg + 69632) + F.wave * 1024;
    int* cidx = (int*)cval + 512;
    __syncthreads();
    for (int e = F.tid; e < 16384; e += 512) { const int key = e >> 7, d = e & 127; k1b[key * 136 + d] = f2bf(F.in[I_PK1][(size_t)l * 16384 + e]); k2b[key * 136 + d] = f2bf(F.in[I_PK2][(size_t)l * 16384 + e]); }
    __syncthreads();
    const int c = F.lane & 15, g = F.lane >> 4;
    const bf16_t* qb = (const bf16_t*)F.qp();
    const int ntask = (nrows / 16) * 8;
    for (int t = F.bid * 8 + F.wave; t < ntask; t += F.G * 8) {
        const int tile = t >> 3, h = t & 7, row = tile * 16 + c;
#pragma unroll
        for (int side = 0; side < 2; ++side) {
            const bf16_t* kb = side ? k2b : k1b;
            bf16x8 qf[4];
#pragma unroll
            for (int s = 0; s < 4; ++s) qf[s] = *(const bf16x8*)(qb + (size_t)row * DM + h * 256 + side * 128 + 32 * s + 8 * g);
            unsigned key[32];
#pragma unroll
            for (int kt = 0; kt < 8; ++kt) { f32x4 acc = (f32x4){0.f, 0.f, 0.f, 0.f};
#pragma unroll
                for (int s = 0; s < 4; ++s) { const bf16x8 kf = *(const bf16x8*)(kb + (kt * 16 + c) * 136 + 32 * s + 8 * g); acc = __builtin_amdgcn_mfma_f32_16x16x32_bf16(kf, qf[s], acc, 0, 0, 0); }
#pragma unroll
                for (int r = 0; r < 4; ++r) key[kt * 4 + r] = ((ford(acc[r]) >> 1) & ~127u) | (unsigned)(127 - (kt * 16 + 4 * g + r));
                if (kt & 1) __builtin_amdgcn_sched_barrier(0); }
            unsigned pre = 0u;
#pragma unroll 1
            for (int bit = 30; bit >= 0; --bit) { const unsigned cand = pre | (1u << bit); int cnt = 32;
#pragma unroll
                for (int i = 0; i < 32; ++i) cnt += ((int)(key[i] - cand)) >> 31;
                cnt += xswi<16>(cnt); cnt += xswi<32>(cnt);
                pre = (cnt >= 16) ? cand : pre; }
            unsigned sel = 0u;
#pragma unroll
            for (int i = 0; i < 32; ++i) sel |= ~(unsigned)(((int)(key[i] - pre)) >> 31) & (1u << i);
            const int mine = __builtin_popcount(sel);
            const int m16 = xswi<16>(mine); const int s2a = mine + m16; const int s2b = xswi<32>(s2a);
            int pos = ((g & 1) ? m16 : 0) + ((g & 2) ? s2b : 0);
#pragma unroll
            for (int i = 0; i < 32; ++i) if ((sel >> i) & 1u) { const unsigned k7 = key[i] & 127u; cval[(c * 2 + side) * 16 + pos] = funord((key[i] & ~127u) << 1); cidx[(c * 2 + side) * 16 + pos] = 127 - (int)k7; ++pos; }
        }
#pragma unroll 1
        for (int ps = 0; ps < 2; ++ps) {
            const int tk = ps * 8 + (F.lane & 7), sub = F.lane >> 3, row2 = tile * 16 + tk;
            float v1[2], v2[16]; int i1[2];
#pragma unroll
            for (int a = 0; a < 2; ++a) { v1[a] = cval[(tk * 2 + 0) * 16 + 2 * sub + a]; i1[a] = cidx[(tk * 2 + 0) * 16 + 2 * sub + a]; }
#pragma unroll
            for (int bb = 0; bb < 16; ++bb) v2[bb] = cval[(tk * 2 + 1) * 16 + bb];
            unsigned key[32];
#pragma unroll
            for (int a = 0; a < 2; ++a)
#pragma unroll
                for (int bb = 0; bb < 16; ++bb) key[a * 16 + bb] = ((ford(v1[a] + v2[bb]) >> 1) & ~255u) | (unsigned)(255 - ((2 * sub + a) * 16 + bb));
            unsigned pre = 0u;
#pragma unroll 1
            for (int bit = 30; bit >= 0; --bit) { const unsigned cand = pre | (1u << bit); int cnt = 32;
#pragma unroll
                for (int i = 0; i < 32; ++i) cnt += ((int)(key[i] - cand)) >> 31;
                cnt += xswi<8>(cnt); cnt += xswi<16>(cnt); cnt += xswi<32>(cnt);
                pre = (cnt >= 16) ? cand : pre; }
            unsigned sel = 0u;
#pragma unroll
            for (int i = 0; i < 32; ++i) sel |= ~(unsigned)(((int)(key[i] - pre)) >> 31) & (1u << i);
            const int mine = __builtin_popcount(sel);
            float mx = -1e30f;
#pragma unroll
            for (int a = 0; a < 2; ++a)
#pragma unroll
                for (int bb = 0; bb < 16; ++bb) { const float sv = v1[a] + v2[bb]; mx = ((sel >> (a * 16 + bb)) & 1u) ? fmaxf(mx, sv) : mx; }
            mx = fmaxf(mx, xsw<8>(mx)); mx = fmaxf(mx, xsw<16>(mx)); mx = fmaxf(mx, xsw<32>(mx));
            float es = 0.f;
#pragma unroll
            for (int a = 0; a < 2; ++a)
#pragma unroll
                for (int bb = 0; bb < 16; ++bb) { const float ev = __expf(v1[a] + v2[bb] - mx); es += ((sel >> (a * 16 + bb)) & 1u) ? ev : 0.f; }
            es += xsw<8>(es); es += xsw<16>(es); es += xsw<32>(es);
            const float inv = 1.f / es;
            const int c8 = xswi<8>(mine); const int p2 = mine + c8; const int c16 = xswi<16>(p2); const int p4 = p2 + c16; const int c32 = xswi<32>(p4);
            int pos = ((sub & 1) ? c8 : 0) + ((sub & 2) ? c16 : 0) + ((sub & 4) ? c32 : 0);
            int* ip = F.idx() + (size_t)row2 * 128 + h * 16; float* gp = F.gate() + (size_t)row2 * 128 + h * 16;
            unsigned m = sel;
            while (m) { const int bi = __builtin_ctz(m); m &= m - 1u; const int a = bi >> 4, bb = bi & 15;
                const float va = a ? v1[1] : v1[0]; const int ia = a ? i1[1] : i1[0];
                ip[pos] = ia * 128 + cidx[(tk * 2 + 1) * 16 + bb]; gp[pos] = __expf(va + cval[(tk * 2 + 1) * 16 + bb] - mx) * inv; ++pos; }
        }
    }
    __syncthreads();
}

#define TK_CE(x, i, j) { const unsigned _a = x[i], _b = x[j]; x[i] = _a > _b ? _a : _b; x[j] = _a > _b ? _b : _a; }
#define TK_SORT16(x) do { TK_CE(x, 0, 1); TK_CE(x, 2, 3); TK_CE(x, 0, 2); TK_CE(x, 1, 3); TK_CE(x, 1, 2); TK_CE(x, 4, 5); TK_CE(x, 6, 7); TK_CE(x, 4, 6); TK_CE(x, 5, 7); TK_CE(x, 5, 6); TK_CE(x, 0, 4); TK_CE(x, 2, 6); TK_CE(x, 2, 4); TK_CE(x, 1, 5); TK_CE(x, 3, 7); TK_CE(x, 3, 5); TK_CE(x, 1, 2); TK_CE(x, 3, 4); TK_CE(x, 5, 6); TK_CE(x, 8, 9); TK_CE(x, 10, 11); TK_CE(x, 8, 10); TK_CE(x, 9, 11); TK_CE(x, 9, 10); TK_CE(x, 12, 13); TK_CE(x, 14, 15); TK_CE(x, 12, 14); TK_CE(x, 13, 15); TK_CE(x, 13, 14); TK_CE(x, 8, 12); TK_CE(x, 10, 14); TK_CE(x, 10, 12); TK_CE(x, 9, 13); TK_CE(x, 11, 15); TK_CE(x, 11, 13); TK_CE(x, 9, 10); TK_CE(x, 11, 12); TK_CE(x, 13, 14); TK_CE(x, 0, 8); TK_CE(x, 4, 12); TK_CE(x, 4, 8); TK_CE(x, 2, 10); TK_CE(x, 6, 14); TK_CE(x, 6, 10); TK_CE(x, 2, 4); TK_CE(x, 6, 8); TK_CE(x, 10, 12); TK_CE(x, 1, 9); TK_CE(x, 5, 13); TK_CE(x, 5, 9); TK_CE(x, 3, 11); TK_CE(x, 7, 15); TK_CE(x, 7, 11); TK_CE(x, 3, 5); TK_CE(x, 7, 9); TK_CE(x, 11, 13); TK_CE(x, 1, 2); TK_CE(x, 3, 4); TK_CE(x, 5, 6); TK_CE(x, 7, 8); TK_CE(x, 9, 10); TK_CE(x, 11, 12); TK_CE(x, 13, 14); } while (0)
#define TK_BMERGE16(x) do { TK_CE(x, 0, 8); TK_CE(x, 1, 9); TK_CE(x, 2, 10); TK_CE(x, 3, 11); TK_CE(x, 4, 12); TK_CE(x, 5, 13); TK_CE(x, 6, 14); TK_CE(x, 7, 15); TK_CE(x, 0, 4); TK_CE(x, 1, 5); TK_CE(x, 2, 6); TK_CE(x, 3, 7); TK_CE(x, 8, 12); TK_CE(x, 9, 13); TK_CE(x, 10, 14); TK_CE(x, 11, 15); TK_CE(x, 0, 2); TK_CE(x, 1, 3); TK_CE(x, 4, 6); TK_CE(x, 5, 7); TK_CE(x, 8, 10); TK_CE(x, 9, 11); TK_CE(x, 12, 14); TK_CE(x, 13, 15); TK_CE(x, 0, 1); TK_CE(x, 2, 3); TK_CE(x, 4, 5); TK_CE(x, 6, 7); TK_CE(x, 8, 9); TK_CE(x, 10, 11); TK_CE(x, 12, 13); TK_CE(x, 14, 15); } while (0)
template <int X> __device__ __forceinline__ void tk_xmerge(unsigned (&T)[16], int xaddr) {
    unsigned M[16];
#pragma unroll
    for (int i = 0; i < 16; ++i) { const unsigned p = (X == 16) ? (unsigned)xswi<16>((int)T[15 - i]) : (unsigned)__builtin_amdgcn_ds_bpermute(xaddr, (int)T[15 - i]); M[i] = T[i] > p ? T[i] : p; }
    TK_BMERGE16(M);
#pragma unroll
    for (int i = 0; i < 16; ++i) T[i] = M[i];
}
__device__ __forceinline__ void phase_topk(Frame& F, int l, int nrows) {
    bf16_t* k1b = (bf16_t*)F.ldsg;
    bf16_t* k2b = k1b + 128 * 136;
    float* cval = (float*)(F.ldsg + 69632) + F.wave * 1024;
    int* cidx = (int*)cval + 512;
    unsigned char* ptab = F.ldsg + 102400;
    __syncthreads();
    for (int e = F.tid; e < 16384; e += 512) { const int key = e >> 7, d = e & 127; k1b[key * 136 + d] = f2bf(F.in[I_PK1][(size_t)l * 16384 + e]); k2b[key * 136 + d] = f2bf(F.in[I_PK2][(size_t)l * 16384 + e]); }
    if (F.tid < 64) { int pa = 0xff, idx = 0;
        for (int a = 0; a < 16; ++a) for (int b = 0; b < 16 / (a + 1); ++b) { if (idx == F.tid) pa = a | (b << 4); ++idx; }
        ptab[F.tid] = (unsigned char)pa; }
    __syncthreads();
    const int c = F.lane & 15, g = F.lane >> 4, xaddr = (F.lane ^ 32) << 2;
    unsigned pt[13];
#pragma unroll
    for (int k = 0; k < 13; ++k) pt[k] = ptab[k * 4 + g];
    const bf16_t* qb = (const bf16_t*)F.qp();
    const int ntask = (nrows / 16) * 8;
    for (int t = F.bid * 8 + F.wave; t < ntask; t += F.G * 8) {
        const int tile = t >> 3, h = t & 7, row = tile * 16 + c;
#pragma unroll
        for (int side = 0; side < 2; ++side) {
            const bf16_t* kb = side ? k2b : k1b;
            bf16x8 qf[4];
#pragma unroll
            for (int s = 0; s < 4; ++s) qf[s] = *(const bf16x8*)(qb + (size_t)row * DM + h * 256 + side * 128 + 32 * s + 8 * g);
            unsigned key[32];
#pragma unroll
            for (int kt = 0; kt < 8; ++kt) { f32x4 acc = (f32x4){0.f, 0.f, 0.f, 0.f};
#pragma unroll
                for (int s = 0; s < 4; ++s) { const bf16x8 kf = *(const bf16x8*)(kb + (kt * 16 + c) * 136 + 32 * s + 8 * g); acc = __builtin_amdgcn_mfma_f32_16x16x32_bf16(kf, qf[s], acc, 0, 0, 0); }
#pragma unroll
                for (int r = 0; r < 4; ++r) key[kt * 4 + r] = ((ford(acc[r]) >> 1) & ~127u) | (unsigned)(127 - (kt * 16 + 4 * g + r));
                if (kt & 1) __builtin_amdgcn_sched_barrier(0); }
            TK_SORT16(key); TK_SORT16((key + 16));
            unsigned T[16];
#pragma unroll
            for (int i = 0; i < 16; ++i) T[i] = key[i] > key[31 - i] ? key[i] : key[31 - i];
            TK_BMERGE16(T);
            tk_xmerge<16>(T, xaddr); tk_xmerge<32>(T, xaddr);
            if (g == 0) {
#pragma unroll
                for (int q = 0; q < 4; ++q) { f32x4 v; u32x4 ix;
#pragma unroll
                    for (int e = 0; e < 4; ++e) { v[e] = funord((T[q * 4 + e] & ~127u) << 1); ix[e] = 127u - (T[q * 4 + e] & 127u); }
                    *(f32x4*)(cval + (c * 2 + side) * 16 + q * 4) = v; *(u32x4*)(cidx + (c * 2 + side) * 16 + q * 4) = ix; } }
        }
        unsigned k2[16];
#pragma unroll
        for (int k = 0; k < 13; ++k) { const int a = pt[k] & 15, b = (pt[k] >> 4) & 15; const float s = cval[(c * 2 + 0) * 16 + a] + cval[(c * 2 + 1) * 16 + b];
            k2[k] = (pt[k] != 0xffu) ? (((ford(s) >> 1) & ~63u) | (unsigned)(63 - (k * 4 + g))) : 0u; }
        k2[13] = 0u; k2[14] = 0u; k2[15] = 0u;
        TK_SORT16(k2);
        tk_xmerge<16>(k2, xaddr); tk_xmerge<32>(k2, xaddr);
        const unsigned p0 = ptab[63 - (k2[0] & 63u)];
        const float mx = cval[(c * 2 + 0) * 16 + (p0 & 15)] + cval[(c * 2 + 1) * 16 + (p0 >> 4)];
        f32x4 ev; u32x4 idv; float es = 0.f;
#pragma unroll
        for (int r = 0; r < 4; ++r) { const unsigned w = (g == 0) ? k2[r] : (g == 1) ? k2[4 + r] : (g == 2) ? k2[8 + r] : k2[12 + r];
            const unsigned p = ptab[63 - (w & 63u)]; const int a = p & 15, b = p >> 4;
            ev[r] = __expf(cval[(c * 2 + 0) * 16 + a] + cval[(c * 2 + 1) * 16 + b] - mx); es += ev[r];
            idv[r] = (unsigned)(cidx[(c * 2 + 0) * 16 + a] * 128 + cidx[(c * 2 + 1) * 16 + b]); }
        es += xsw<16>(es); es += xsw<32>(es);
        const float inv = 1.f / es;
        *(u32x4*)(F.idx() + (size_t)row * 128 + h * 16 + 4 * g) = idv;
        *(f32x4*)(F.gate() + (size_t)row * 128 + h * 16 + 4 * g) = ev * inv;
    }
    __syncthreads();
}

__device__ __forceinline__ void phase_cvt_uv(Frame& F, int l) {
    unsigned char* gb = (unsigned char*)F.g();
    constexpr int NR = 2 * NEXP;
    auto load_row = [&](int r_, f32x4 (&x)[8]) { const int r = min(r_, NR - 1); const bool isv = r >= NEXP; const int e = isv ? r - NEXP : r;
        const float* src = F.in[isv ? I_PV : I_PU] + ((size_t)l * NEXP + e) * DM;
#pragma unroll
        for (int i = 0; i < 2; ++i)
#pragma unroll
            for (int q = 0; q < 4; ++q) x[i * 4 + q] = __builtin_nontemporal_load((const f32x4*)(src + i * 1024 + F.lane * 16 + q * 4)); };
    auto store_row = [&](int r, const f32x4 (&x)[8]) { const bool isv = r >= NEXP; const int e = isv ? r - NEXP : r; float mx = 0.f;
#pragma unroll
        for (int i = 0; i < 8; ++i) mx = fmaxf(mx, fmaxf(fmaxf(fabsf(x[i][0]), fabsf(x[i][1])), fmaxf(fabsf(x[i][2]), fabsf(x[i][3]))));
        mx = wmax(mx);
        const float qm = 127.f;
        const float sc = (mx > 0.f) ? qm / mx : 1.f, isc = (mx > 0.f) ? mx / qm : 1.f;
        unsigned char* dst = gb + (isv ? PE_V8 : PE_U8) + (size_t)e * DM;
#pragma unroll
        for (int i = 0; i < 2; ++i) { u32x4 w;
#pragma unroll
            for (int q = 0; q < 4; ++q) {
                { const int q0 = (int)__builtin_rintf(x[i * 4 + q][0] * sc), q1 = (int)__builtin_rintf(x[i * 4 + q][1] * sc), q2 = (int)__builtin_rintf(x[i * 4 + q][2] * sc), q3 = (int)__builtin_rintf(x[i * 4 + q][3] * sc);
                    w[q] = (unsigned)(q0 & 255) | ((unsigned)(q1 & 255) << 8) | ((unsigned)(q2 & 255) << 16) | ((unsigned)q3 << 24); } }
            *(u32x4*)(dst + i * 1024 + F.lane * 16) = w; }
        if (F.lane == 0) *(float*)(gb + (isv ? PE_SV : PE_SU) + (size_t)e * 4) = isc; };
    f32x4 xa[8], xb[8];
    const int st = F.G * 8;
    int r = F.bid * 8 + F.wave;
    if (r >= NR) return;
    load_row(r, xa);
#pragma unroll 1
    for (; r < NR; r += 2 * st) {
        load_row(r + st, xb);
        store_row(r, xa);
        load_row(r + 2 * st, xa);
        if (r + st < NR) store_row(r + st, xb);
    }
}
constexpr int PG_NS = 16, PG_CH = 64, PG_NCHMAX = MR / PG_CH;
__device__ __forceinline__ void cvt16(u32x4 w, float (&f)[16]) {
#pragma unroll
    for (int q = 0; q < 4; ++q) { const f32x2 a = __builtin_amdgcn_cvt_pk_f32_fp8((int)w[q], false), b = __builtin_amdgcn_cvt_pk_f32_fp8((int)w[q], true); f[q * 4] = a[0]; f[q * 4 + 1] = a[1]; f[q * 4 + 2] = b[0]; f[q * 4 + 3] = b[1]; } }
template <int X1, int X2, int X3>
__device__ __forceinline__ void bfly16(float (&d)[16], int lane, float& o0, float& o1) {
    const bool b1 = lane & X1, b2 = lane & X2, b3 = lane & X3; float r1[8], r2[4];
#pragma unroll
    for (int i = 0; i < 8; ++i) r1[i] = (b1 ? d[8 + i] : d[i]) + xsw<X1>(b1 ? d[i] : d[8 + i]);
#pragma unroll
    for (int i = 0; i < 4; ++i) r2[i] = (b2 ? r1[4 + i] : r1[i]) + xsw<X2>(b2 ? r1[i] : r1[4 + i]);
    o0 = (b3 ? r2[2] : r2[0]) + xsw<X3>(b3 ? r2[0] : r2[2]); o1 = (b3 ? r2[3] : r2[1]) + xsw<X3>(b3 ? r2[1] : r2[3]);
}
template <int PASS>
__device__ __forceinline__ void phase_peer_slice(Frame& F, int l, int nrows, float* xlat, float* xctx, int qbase, const float* xin_lat = nullptr, const float* xin_ctx = nullptr, const bf16_t* delta = nullptr) {
    const unsigned char* gb = (const unsigned char*)F.g();
    const unsigned char* T8 = gb + (PASS ? PE_V8 : PE_U8);
    float* part = F.mp();
    const int nch = nrows / PG_CH;
    const int xcc = (int)(__builtin_amdgcn_s_getreg((3 << 11) | 20) & 7u);
    const int p8 = F.lane & 7, e8 = F.lane >> 3;
    LAS int* sidx = (LAS int*)F.lds;
    LAS unsigned char* sa8 = F.lds + 32768;
    LAS float* sst = (LAS float*)(F.lds + 32768 + 8192);
    const unsigned char* A8 = (const unsigned char*)F.dt(); const float* AST = F.dtr();
    LAS unsigned char* shq = F.lds + 32768;
    LAS float* shs = (LAS float*)(F.lds + 32768 + 8192);
    for (int so = 0; so < PG_NS; ++so) {
        const int s = (2 * xcc + so) & (PG_NS - 1);
        for (;;) {
            const int ch = next_unit(F, qbase + s);
            if (ch >= nch) break;
            for (int e = F.tid; e < 2048; e += 512) *(LAS u32x4*)(sidx + e * 4) = *(const u32x4*)(F.idx() + (size_t)ch * PG_CH * 128 + e * 4);
            if (PASS == 1) { *(LAS u32x4*)(sa8 + F.tid * 16) = *(const u32x4*)(A8 + (size_t)ch * PG_CH * 128 + F.tid * 16); if (F.tid < 64) sst[F.tid] = AST[ch * PG_CH + F.tid]; }
            if (PASS == 0) { { const int r = F.tid >> 3, c16 = F.tid & 7; *(LAS u32x4*)(shq + r * 128 + c16 * 16) = *(const u32x4*)(gb + PE_HQ + (size_t)(ch * PG_CH + r) * DM + s * 128 + c16 * 16); }
                if (F.tid < 64) shs[F.tid] = *(const float*)(gb + PE_HS + ((size_t)(ch * PG_CH + F.tid) * 16 + s) * 4); }
            __syncthreads();
            u32x4 wA[8], wB[8];
            auto issue = [&](int tk, int hf, u32x4 (&w)[8]) {
#pragma unroll
                for (int i = 0; i < 8; ++i) { const int id = sidx[tk * 128 + 8 * (hf * 8 + i) + e8]; w[i] = *(const u32x4*)(T8 + (size_t)id * DM + s * 128 + p8 * 16); } };
            issue(F.wave, 0, wA);
            auto token = [&](auto LC, int j) { constexpr int LAST = decltype(LC)::value; const int tk = F.wave + 8 * j, row = ch * PG_CH + tk;
                float d[16]; u32x4 hq = (u32x4){0u, 0u, 0u, 0u}; float hsc = 0.f; int acc[16]; unsigned aq[4] = {0u, 0u, 0u, 0u};
                if (PASS == 0) { hq = *(LAS const u32x4*)(shq + tk * 128 + p8 * 16); hsc = shs[tk]; }
                else { hsc = sst[tk];
#pragma unroll
                    for (int q = 0; q < 4; ++q) aq[q] = *(LAS const unsigned*)(sa8 + tk * 128 + (q * 8 + e8) * 4);
#pragma unroll
                    for (int q = 0; q < 16; ++q) acc[q] = 0; }
                auto half = [&](int hf, const u32x4 (&w)[8]) {
                    if (PASS == 0) {
#pragma unroll
                        for (int i = 0; i < 8; ++i) { u32x4 wi = w[i]; asm volatile("" : "+v"(wi));
                            int di = __builtin_amdgcn_sdot4((int)wi.x, (int)hq.x, 0, false); di = __builtin_amdgcn_sdot4((int)wi.y, (int)hq.y, di, false);
                            di = __builtin_amdgcn_sdot4((int)wi.z, (int)hq.z, di, false); di = __builtin_amdgcn_sdot4((int)wi.w, (int)hq.w, di, false); d[hf * 8 + i] = (float)di; }
                    } else {
#pragma unroll
                        for (int g2 = 0; g2 < 2; ++g2) { u32x4 r0 = w[g2 * 4 + 0], r1 = w[g2 * 4 + 1], r2 = w[g2 * 4 + 2], r3 = w[g2 * 4 + 3]; asm volatile("" : "+v"(r0), "+v"(r1), "+v"(r2), "+v"(r3));
                            const int a4 = (int)aq[hf * 2 + g2];
#pragma unroll
                            for (int jd = 0; jd < 4; ++jd) {
                                const unsigned lo01 = __builtin_amdgcn_perm(r1[jd], r0[jd], 0x05010400u), hi01 = __builtin_amdgcn_perm(r1[jd], r0[jd], 0x07030602u);
                                const unsigned lo23 = __builtin_amdgcn_perm(r3[jd], r2[jd], 0x05010400u), hi23 = __builtin_amdgcn_perm(r3[jd], r2[jd], 0x07030602u);
                                const unsigned t0 = __builtin_amdgcn_perm(lo23, lo01, 0x05040100u), t1 = __builtin_amdgcn_perm(lo23, lo01, 0x07060302u);
                                const unsigned t2 = __builtin_amdgcn_perm(hi23, hi01, 0x05040100u), t3 = __builtin_amdgcn_perm(hi23, hi01, 0x07060302u);
                                acc[jd * 4 + 0] = __builtin_amdgcn_sdot4((int)t0, a4, acc[jd * 4 + 0], false); acc[jd * 4 + 1] = __builtin_amdgcn_sdot4((int)t1, a4, acc[jd * 4 + 1], false);
                                acc[jd * 4 + 2] = __builtin_amdgcn_sdot4((int)t2, a4, acc[jd * 4 + 2], false); acc[jd * 4 + 3] = __builtin_amdgcn_sdot4((int)t3, a4, acc[jd * 4 + 3], false); } }
                    } };
                f32x2 xres = (f32x2){0.f, 0.f}, gres = (f32x2){0.f, 0.f}; float* xp = nullptr;
                if (PASS == 1) { const int j0 = ((e8 & 1) ? 8 : 0) + ((e8 & 2) ? 4 : 0) + ((e8 & 4) ? 2 : 0); const int col = s * 128 + p8 * 16 + j0;
                    const bool lat = row < RX; const int jb = lat ? (row >> 12) : 4;
                    xp = (lat ? xlat + (size_t)row * DM : xctx + (size_t)(row - RX) * DM) + col; const float* gp = F.mod() + ((size_t)(l * 5 + jb) * 6 + 5) * DM + col;
                    const float* xi = (lat ? xin_lat + (size_t)row * DM : xin_ctx + (size_t)(row - RX) * DM) + col;
                    const unsigned dw = *(const unsigned*)(delta + (size_t)row * DM + col);
                    xres = *(const f32x2*)xi; xres[0] += lo2f(dw); xres[1] += hi2f(dw); gres = *(const f32x2*)gp; }
                issue(tk, 1, wB);
                asm volatile("" ::: "memory");
                half(0, wA);
                asm volatile("" ::: "memory");
                if (LAST == 0) issue(tk + 8, 0, wA);
                asm volatile("" ::: "memory");
                half(1, wB);
                if (PASS == 0) {
                    float o0, o1; bfly16<1, 2, 4>(d, F.lane, o0, o1);
                    const int i0 = ((p8 & 1) ? 8 : 0) + ((p8 & 2) ? 4 : 0) + ((p8 & 4) ? 2 : 0);
                    float* pp = part + ((size_t)s * MR + row) * 128 + e8;
                    pp[8 * i0] = o0 * hsc; pp[8 * (i0 + 1)] = o1 * hsc;
                } else {
#pragma unroll
                    for (int q = 0; q < 16; ++q) d[q] = (float)acc[q];
                    float o0, o1; bfly16<8, 16, 32>(d, F.lane, o0, o1);
                    const float osc = hsc;
                    xres[0] += gres[0] * o0 * osc; xres[1] += gres[1] * o1 * osc; *(f32x2*)xp = xres;
                }
            };
#pragma unroll 1
            for (int j = 0; j < 7; ++j) token(std::integral_constant<int, 0>{}, j);
            token(std::integral_constant<int, 1>{}, 7);
        }
    }
}
__device__ __forceinline__ void phase_peer_act(Frame& F, int l, int nrows) {
    const unsigned char* gb = (const unsigned char*)F.g(); const float* SU = (const float*)(gb + PE_SU); const float* SV = (const float*)(gb + PE_SV);
    const float* part = F.mp(); unsigned char* A8 = (unsigned char*)F.dt(); float* AST = F.dtr();
    for (int t = F.bid * 8 + F.wave; t < nrows; t += F.G * 8) {
        float a[2];
#pragma unroll
        for (int h = 0; h < 2; ++h) { const size_t i = (size_t)t * 128 + F.lane + 64 * h; float z = 0.f;
#pragma unroll
            for (int s = 0; s < PG_NS; ++s) z += part[(size_t)s * MR * 128 + i];
            const int e = F.idx()[i]; z *= SU[e];
            a[h] = 0.5f * z * (1.f + erff(z * 0.70710678118f)) * F.gate()[i] * SV[e]; }
        const float m = wmax(fmaxf(fabsf(a[0]), fabsf(a[1])));
        const float sc = (m > 0.f) ? 127.f / m : 0.f;
#pragma unroll
        for (int h = 0; h < 2; ++h) { const int k = F.lane + 64 * h, e8 = k & 7, i_ = k >> 3; const int q = (int)__builtin_rintf(a[h] * sc);
            A8[(size_t)t * 128 + ((i_ >> 2) * 8 + e8) * 4 + (i_ & 3)] = (unsigned char)(q & 255); }
        if (F.lane == 0) AST[t] = m * (1.f / 127.f);
    }
}
constexpr int LDS_BYTES = 147456;
constexpr int NPH_L = 13, NPH = 1 + DEPTH * NPH_L;
#ifndef MK_MULTI
#define MK_MULTI 0
#endif

__device__ __forceinline__ bool in_phase(int lo, int hi, int k) { asm volatile("" : "+s"(lo), "+s"(hi)); return lo <= k && k < hi; }
__global__ void __launch_bounds__(512, 2) mega(Params P) {
    extern __shared__ __attribute__((aligned(16))) unsigned char smem[];
    Frame F;
    F.in = P.in; F.in0 = P.in; F.out = P.out; F.ws = P.ws; F.lds = (LAS unsigned char*)smem; F.ldsg = smem;
    F.G = gridDim.x; F.bid = blockIdx.x; F.init_ids(); F.refresh(P.ws);
    const int lo = P.ph_lo, hi = P.ph_hi;
    const bool single = (hi - lo) > 1;
    volatile LAS unsigned* st = (volatile LAS unsigned*)(F.lds + 147424);
    if (F.tid < 4) st[F.tid] = 0u;
    __syncthreads();
    XcdBarrier bar; bar.bar = F.ctl() + CW_BAR; bar.x = 0; bar.st = st;
    if (single) bar = xcd_barrier_post(F.ctl() + CW_BAR, st, F.tid);
#if defined(PH_ONLY)
#define EN(k) ((k) == PH_ONLY)
#elif defined(PH_MASK)
#define EN(k) (((PH_MASK) >> (k)) & 1)
#else
#define EN(k) 1
#endif
#define IN(k) in_phase(lo, hi, (k))
#ifndef REPEAT_KIND
#define REPEAT_KIND -1
#endif
#define RPT(kind) (((kind) == REPEAT_KIND) ? 2 : 1)
#define SEAM(k) do { if (IN(k) && IN((k) + 1)) xcd_barrier_t<false>(bar, F.tid); } while (0)
    for (int rp = 0; rp < RPT(0); ++rp) if (EN(0) && IN(0)) { F.refresh(P.ws); phase_mod(F); }
    if (IN(0) && IN(1)) xcd_barrier_t<true>(bar, F.tid);
    auto layer = [&](auto LC) {
        constexpr int l = decltype(LC)::value;
        const int pb = 1 + l * NPH_L;
        const float* xs = l ? F.out : F.in[I_X]; const float* cs = l ? F.ctxs() : F.in[I_CTX];
        const int nr2 = l ? RX : MR;
        float* modl = F.mod() + (size_t)l * 5 * 6 * DM;
        for (int rp = 0; rp < RPT(1); ++rp) if (EN(1) && IN(pb + 0)) { F.refresh(P.ws); phase_wcvt(F, l); phase_norm(F, l, 0, xs, cs, MR); }
        SEAM(pb + 0);
        for (int rp = 0; rp < RPT(2); ++rp) if (EN(2) && IN(pb + 1)) { F.refresh(P.ws); pg8::Gemm g{F.hn(), F.win(), MR, INP, DM}; pg8::StaticOrder S; S.init(MR, INP, F.G, F.bid); pg8::EpiInProj E{F.p1(), (unsigned char*)F.g(), F.dtr(), F.glr()};
            pg8::gemm_phase<pg8::EpiInProj, pg8::StaticOrder, false, true>(F.lds, g, S, E, F.tid); }
        SEAM(pb + 1);
        if (EN(3) && IN(pb + 2)) { F.refresh(P.ws); phase_prep(F, l); }
        if (REPEAT_KIND == 3) { if (EN(3) && IN(pb + 2)) { F.refresh(P.ws); phase_prep(F, l, true); } }
        SEAM(pb + 2);
        for (int rp = 0; rp < ((REPEAT_KIND >= 40 && REPEAT_KIND <= 43) ? 2 : RPT(4)); ++rp) if (EN(4) && IN(pb + 3)) { F.refresh(P.ws); phase_mix(F, l, l + 2 * rp, (rp == 1 && REPEAT_KIND >= 40 && REPEAT_KIND <= 43) ? (REPEAT_KIND - 39) : 0); }
        SEAM(pb + 3);
        for (int rp = 0; rp < RPT(5); ++rp) if (EN(5) && IN(pb + 4)) { F.refresh(P.ws); phase_fin(F, l, nr2); }
        SEAM(pb + 4);
        for (int rp = 0; rp < RPT(6); ++rp) if (EN(6) && IN(pb + 5)) { F.refresh(P.ws); pg8::Gemm g{F.outs(), F.wbr(), RX, DM, 4096}; pg8::StaticOrder S; S.init(RX, DM, F.G, F.bid); pg8::EpiMerge E{(const unsigned char*)F.g(), F.mb()};
            pg8::gemm_phase<pg8::EpiMerge, pg8::StaticOrder, true, true>(F.lds, g, S, E, F.tid);
            if constexpr (l == 0) { for (int r2 = 0; r2 < RPT(20); ++r2) { F.refresh(P.ws); ctx_gemm<0>(F, l, cs, modl); } } }
        SEAM(pb + 5);
        for (int rp = 0; rp < ((l == 0) ? RPT(10) : 1); ++rp) if (EN(10) && IN(pb + 6)) { F.refresh(P.ws); pg8::Gemm g{F.mb(), F.wout(), RX, DM, DM}; pg8::StaticOrder S; S.init(RX, DM, F.G, F.bid); pg8::EpiDelta E{F.ys(), modl, 2};
            pg8::gemm_phase<pg8::EpiDelta, pg8::StaticOrder, true, true>(F.lds, g, S, E, F.tid);
            if constexpr (l == 0) { for (int r2 = 0; r2 < RPT(20); ++r2) { F.refresh(P.ws); ctx_gemm<1>(F, l, cs, modl); } } }
        SEAM(pb + 6);
        for (int rp = 0; rp < RPT(11); ++rp) if (EN(11) && IN(pb + 7)) { F.refresh(P.ws); phase_norm(F, l, 1, xs, cs, nr2, F.ys()); phase_cvt_uv(F, l); }
        SEAM(pb + 7);
        for (int rp = 0; rp < RPT(12); ++rp) if (EN(12) && IN(pb + 8)) { F.refresh(P.ws); pg8::Gemm g{F.hn(), F.wq(), RX, DM, DM}; pg8::StaticOrder S; S.init(RX, DM, F.G, F.bid); pg8::EpiBf16P E{(bf16_t*)F.qp(), DM};
            pg8::gemm_phase<pg8::EpiBf16P, pg8::StaticOrder, true, true>(F.lds, g, S, E, F.tid);
            if constexpr (l == 0) { for (int r2 = 0; r2 < RPT(20); ++r2) { F.refresh(P.ws); ctx_gemm<2>(F, l, cs, modl); } } }
        SEAM(pb + 8);
        for (int rp = 0; rp < RPT(13); ++rp) if (EN(13) && IN(pb + 9)) { F.refresh(P.ws); phase_topk(F, l, nr2); }
        SEAM(pb + 9);
        for (int rp = 0; rp < RPT(14); ++rp) if (EN(14) && IN(pb + 10)) { F.refresh(P.ws); phase_peer_slice<0>(F, l, nr2, F.out, F.ctxs(), 8 + l * 32 + 72 * rp); }
        SEAM(pb + 10);
        if (EN(15) && IN(pb + 11)) { F.refresh(P.ws); phase_peer_act(F, l, nr2); }
        SEAM(pb + 11);
        if (RPT(16) == 2) { if (EN(16) && IN(pb + 12)) { F.refresh(P.ws); phase_peer_slice<1>(F, l, nr2, F.qp(), F.qp() + (size_t)RX * DM, 8 + l * 32 + 16 + 72, xs, cs, F.ys()); } }
        if (EN(16) && IN(pb + 12)) { F.refresh(P.ws); phase_peer_slice<1>(F, l, nr2, F.out, F.ctxs(), 8 + l * 32 + 16, xs, cs, F.ys()); }
        SEAM(pb + 12);
    };
    layer(std::integral_constant<int, 0>{});
    layer(std::integral_constant<int, 1>{});
#undef IN
#undef SEAM
}

extern "C" void kernel_launch(void* const* d_in, const int* in_sizes, int n_in, void* d_out, int out_size, void* d_ws, size_t ws_size, hipStream_t stream) {
    static int grid = 0;
    if (grid == 0) {
        int dev = 0, cus = 0, per_cu = 0;
        if (hipGetDevice(&dev) != hipSuccess || hipDeviceGetAttribute(&cus, hipDeviceAttributeMultiprocessorCount, dev) != hipSuccess) { fprintf(stderr, "kernel_launch: device query failed\n"); grid = -1; return; }
        if (hipFuncSetAttribute((const void*)mega, hipFuncAttributeMaxDynamicSharedMemorySize, LDS_BYTES) != hipSuccess) { fprintf(stderr, "kernel_launch: hipFuncSetAttribute failed\n"); grid = -1; return; }
        if (hipOccupancyMaxActiveBlocksPerMultiprocessor(&per_cu, (const void*)mega, 512, LDS_BYTES) != hipSuccess || per_cu < 1) fprintf(stderr, "kernel_launch: occupancy query says %d\n", per_cu);
        (void)hipGetLastError();
        grid = cus;
        if (n_in != 31 || out_size != RX * DM || ws_size < WS_END) { fprintf(stderr, "kernel_launch: unexpected shapes (n_in %d out %d ws %zu need %zu)\n", n_in, out_size, ws_size, (size_t)WS_END); grid = -1; return; }
    }
    if (grid < 0) return;
    if (hipMemsetAsync((char*)d_ws + WS_CTL, 0, CTL_BYTES, stream) != hipSuccess) { fprintf(stderr, "kernel_launch: memset failed\n"); return; }
    Params p{};
    for (int i = 0; i < 31; ++i) p.in[i] = (const float*)d_in[i];
    p.out = (float*)d_out; p.ws = (unsigned char*)d_ws;
#if MK_MULTI
    for (int ph = 0; ph < NPH; ++ph) { p.ph_lo = ph; p.ph_hi = ph + 1; hipLaunchKernelGGL(mega, dim3(grid), dim3(512), LDS_BYTES, stream, p);
#ifdef DBG_NAIVE
        if (ph == 1 + 3 || ph == 1 + NPH_L + 3) { const int l = (ph - 1) / NPH_L; hipLaunchKernelGGL(ssd_naive, dim3(32), dim3(256), 0, stream, p, l); hipLaunchKernelGGL(gla_naive, dim3(32), dim3(256), 0, stream, p, l); }
#endif
    }
#else
    p.ph_lo = 0; p.ph_hi = NPH; hipLaunchKernelGGL(mega, dim3(grid), dim3(512), LDS_BYTES, stream, p);
#endif
    const hipError_t le = hipPeekAtLastError();
    if (le != hipSuccess) fprintf(stderr, "kernel_launch: launch failed: %s\n", hipGetErrorName(le));
}
```

```cpp
#include <hip/hip_runtime.h>
#include <cstdio>
#include <cstdint>
#include <type_traits>

#define LAS __attribute__((address_space(3)))
typedef unsigned short bf16_t;
typedef short bf16x8 __attribute__((ext_vector_type(8)));
typedef float f32x4 __attribute__((ext_vector_type(4)));
typedef float f32x2 __attribute__((ext_vector_type(2)));
typedef unsigned u32x4 __attribute__((ext_vector_type(4)));
typedef unsigned u32x2 __attribute__((ext_vector_type(2)));
typedef __bf16 bf2_t __attribute__((ext_vector_type(2)));
typedef __bf16 bf8_t __attribute__((ext_vector_type(8)));

constexpr int DM = 2048, NB = 4, SEQ = 4096, LCTX = 256, DEPTH = 2;
constexpr int RX = NB * SEQ;
constexpr int RC = NB * LCTX;
constexpr int MR = RX + RC;
constexpr int INW = 19008;
constexpr int INP = 19200;
constexpr int P1W = 10752;
constexpr int GW = 8192;
constexpr int C_Z = 0, C_XBC = 1024, C_NA = 3072, C_GQ = 6144, C_GK = 6656, C_GV = 7168, C_GR = 8192, C_SQ = 9216, C_SK = 10240, C_SV = 10496;
constexpr float EPS = 1e-6f;
constexpr int NEXP = 16384;

constexpr size_t al256(size_t x) { return (x + 255) & ~(size_t)255; }
constexpr size_t WS_CTL = 0;                                  constexpr size_t CTL_BYTES = 1u << 20;
constexpr size_t WS_MOD = WS_CTL + CTL_BYTES;                 constexpr size_t MOD_BYTES = al256((size_t)DEPTH * 5 * 6 * DM * 4);
constexpr size_t WS_WIN = WS_MOD + MOD_BYTES;                 constexpr size_t WIN_BYTES = (size_t)INP * DM * 2;
constexpr size_t WS_WBR = WS_WIN + WIN_BYTES;                 constexpr size_t WBR_BYTES = (size_t)4 * DM * 1024 * 2;
constexpr size_t WS_WOUT = WS_WBR + WBR_BYTES;                constexpr size_t WOUT_BYTES = (size_t)DM * DM * 2;
constexpr size_t WS_WQ = WS_WOUT + WOUT_BYTES;                constexpr size_t WQ_BYTES = (size_t)DM * DM * 2;
constexpr size_t WS_HN = WS_WQ + WQ_BYTES;                    constexpr size_t HN_BYTES = (size_t)MR * DM * 2;
constexpr size_t WS_P1 = WS_HN + HN_BYTES;                    constexpr size_t P1_BYTES = (size_t)MR * P1W * 2;
constexpr size_t WS_G = WS_P1 + P1_BYTES;                     constexpr size_t G_BYTES = (size_t)MR * GW * 2;
constexpr size_t WS_DTR = WS_G + G_BYTES;                     constexpr size_t DTR_BYTES = (size_t)MR * 32 * 4;
constexpr size_t WS_GLR = WS_DTR + DTR_BYTES;                 constexpr size_t GLR_BYTES = (size_t)MR * 32 * 4;
constexpr size_t WS_DT = WS_GLR + GLR_BYTES;                  constexpr size_t DT_BYTES = (size_t)MR * 32 * 4;
constexpr size_t WS_YS = WS_DT + DT_BYTES;                    constexpr size_t YS_BYTES = (size_t)2 * MR * 1024 * 2;
constexpr size_t WS_OG = WS_YS + YS_BYTES;                    constexpr size_t OG_BYTES = (size_t)2 * MR * 1024 * 2;
constexpr size_t WS_OUTS = WS_OG + OG_BYTES;                  constexpr size_t OUTS_BYTES = (size_t)4 * MR * 1024 * 2;
constexpr size_t WS_CTXS = WS_OUTS + OUTS_BYTES;              constexpr size_t CTXS_BYTES = (size_t)RC * DM * 4;
constexpr size_t WS_IDX = WS_CTXS + CTXS_BYTES;               constexpr size_t IDX_BYTES = (size_t)MR * 128 * 4;
constexpr size_t WS_GATE = WS_IDX + IDX_BYTES;                constexpr size_t GATE_BYTES = (size_t)MR * 128 * 4;
constexpr int VTS = SEQ + LCTX;
constexpr size_t WS_VTNA = WS_GATE + GATE_BYTES;              constexpr size_t VTNA_BYTES = (size_t)NB * 16 * 64 * VTS * 2;
constexpr size_t WS_VTSW = WS_VTNA + VTNA_BYTES;              constexpr size_t VTSW_BYTES = (size_t)NB * 4 * 64 * VTS * 2;
constexpr size_t WS_GCUM = WS_VTSW + VTSW_BYTES;              constexpr size_t GCUM_BYTES = (size_t)2 * MR * 512 * 4;
constexpr size_t WS_CSUM = WS_GCUM + GCUM_BYTES;              constexpr size_t CSUM_BYTES = (size_t)2 * MR * 16 * 4;
constexpr size_t WS_END = WS_CSUM + CSUM_BYTES;
constexpr size_t WS_MP = WS_P1;
constexpr size_t WS_MB = WS_MP + (size_t)MR * DM * 4;
constexpr size_t WS_QP = WS_MB + (size_t)MR * DM * 2;
static_assert(WS_QP + (size_t)MR * DM * 4 <= WS_P1 + P1_BYTES, "overlay");

constexpr size_t PE_U8 = 0, PE_V8 = (size_t)NEXP * DM, PE_SU = 2 * (size_t)NEXP * DM, PE_SV = PE_SU + (size_t)NEXP * 4;
constexpr size_t PE_HQ = PE_SV + (size_t)NEXP * 4;
constexpr size_t PE_HS = PE_HQ + (size_t)MR * DM;
static_assert(PE_HS + (size_t)MR * 16 * 4 <= G_BYTES, "PEER overlay");
constexpr int CW_BAR = 0;
constexpr int CW_Q = 4096;

__device__ __forceinline__ float bf2f(bf16_t v) { return __uint_as_float(((unsigned)v) << 16); }
__device__ __forceinline__ bf16_t f2bf(float f) { unsigned u = __float_as_uint(f); u += 0x7FFFu + ((u >> 16) & 1u); return (bf16_t)(u >> 16); }
typedef float f2cv_t __attribute__((ext_vector_type(2)));
__device__ __forceinline__ unsigned pack2(float lo, float hi) { const f2cv_t v = {lo, hi}; return __builtin_bit_cast(unsigned, __builtin_convertvector(v, bf2_t)); }
__device__ __forceinline__ float lo2f(unsigned w) { return __uint_as_float(w << 16); }
__device__ __forceinline__ float hi2f(unsigned w) { return __uint_as_float(w & 0xffff0000u); }
template <int M> __device__ __forceinline__ int xswi(int v) {
    if constexpr (M < 32) return __builtin_amdgcn_ds_swizzle(v, (M << 10) | 0x1f);
    else { const auto r = __builtin_amdgcn_permlane32_swap((unsigned)v, (unsigned)v, false, false); return (int)(r[0] ^ r[1] ^ (unsigned)v); }
}
template <int M> __device__ __forceinline__ float xsw(float v) { return __int_as_float(xswi<M>(__float_as_int(v))); }
__device__ __forceinline__ float wsum(float v) { v += xsw<32>(v); v += xsw<16>(v); v += xsw<8>(v); v += xsw<4>(v); v += xsw<2>(v); v += xsw<1>(v); return v; }
__device__ __forceinline__ float wmax(float v) { v = fmaxf(v, xsw<32>(v)); v = fmaxf(v, xsw<16>(v)); v = fmaxf(v, xsw<8>(v)); v = fmaxf(v, xsw<4>(v)); v = fmaxf(v, xsw<2>(v)); v = fmaxf(v, xsw<1>(v)); return v; }
__device__ __forceinline__ float rlane(float v, int l) { return __int_as_float(__builtin_amdgcn_readlane(__float_as_int(v), l)); }
__device__ __forceinline__ float siluf(float x) { return x * __builtin_amdgcn_rcpf(1.f + __expf(-x)); }
__device__ __forceinline__ float sigmf(float x) { return __builtin_amdgcn_rcpf(1.f + __expf(-x)); }
#define MK_MULTI 0
#define XB_TMO      128
#define XB_XCNT(j)  (256  + 64 * (j))
#define XB_XSUB(j)  (1280 + 64 * (j))
#define XB_XGEN(j)  (2304 + 64 * (j))
#define XB_TOP      3328
#define XB_TOPGEN   3392
#define XCD_BAR_WORDS 3456
#define XB_SPIN_CAP (1u << 18)

__device__ __forceinline__ unsigned xb_ld(unsigned* p)              { return __hip_atomic_load(p, __ATOMIC_RELAXED, __HIP_MEMORY_SCOPE_AGENT); }
__device__ __forceinline__ unsigned xb_add(unsigned* p, unsigned v) { return __hip_atomic_fetch_add(p, v, __ATOMIC_RELAXED, __HIP_MEMORY_SCOPE_AGENT); }
__device__ __forceinline__ unsigned xb_xcc_id() { return (unsigned)__builtin_amdgcn_s_getreg((3 << 11) | 20) & 0xFu; }
#define XB_SPIN(cond, bar) do { unsigned _sp = 0; while (cond) { __builtin_amdgcn_s_sleep(1); \
    if ((++_sp & 255u) == 0u) { if (xb_ld(&(bar)[XB_TMO])) break; if (_sp > XB_SPIN_CAP) { atomicAdd(&(bar)[XB_TMO], 1u); break; } } } } while (0)

struct XcdBarrier {
    unsigned* bar; unsigned x;
    volatile LAS unsigned* st;
};

__device__ __forceinline__ XcdBarrier xcd_barrier_post(unsigned* bar, volatile LAS unsigned* st, int tid) {
    XcdBarrier b; b.bar = bar; b.x = xb_xcc_id(); b.st = st;
    if (tid == 0) (void)xb_add(&bar[XB_XCNT(b.x)], 1u);
    return b;
}
__device__ __forceinline__ void xcd_barrier_complete(unsigned* bar, unsigned x, unsigned& nloc, unsigned& nx) {
    const unsigned G = gridDim.x * gridDim.y * gridDim.z;
    unsigned sum, cnt, mine, sp = 0u;
    for (;;) {
        sum = 0u; cnt = 0u; mine = 0u;
#pragma unroll
        for (unsigned j = 0; j < 16; ++j) { const unsigned c = xb_ld(&bar[XB_XCNT(j)]); sum += c; cnt += (c > 0u) ? 1u : 0u; mine = (j == x) ? c : mine; }
        if (sum == G) break;
        __builtin_amdgcn_s_sleep(1);
        if ((++sp & 255u) == 0u) { if (xb_ld(&bar[XB_TMO])) break; if (sp > XB_SPIN_CAP) { atomicAdd(&bar[XB_TMO], 1u); break; } }
    }
    nloc = mine > 0u ? mine : 1u; nx = cnt > 0u ? cnt : 1u;
}

template <bool FIRST>
__device__ __forceinline__ void xcd_barrier_t(const XcdBarrier& b, int tid) {
    asm volatile("s_waitcnt vmcnt(0)" ::: "memory");
    __syncthreads();
    if (tid == 0) {
        unsigned* bar = b.bar;
        __builtin_amdgcn_s_waitcnt(0);
        unsigned nloc = b.st[0], nx = b.st[1];
        if constexpr (FIRST) { if (nloc == 0u) { xcd_barrier_complete(bar, b.x, nloc, nx); b.st[0] = nloc; b.st[1] = nx; } }
        const unsigned old = xb_add(&bar[XB_XSUB(b.x)], 1u);
        const unsigned gen = old / nloc;
        if (old + 1u == (gen + 1u) * nloc) {
            __builtin_amdgcn_fence(__ATOMIC_RELEASE, "agent");
            asm volatile("s_waitcnt vmcnt(0)" ::: "memory");
            const unsigned og = xb_add(&bar[XB_TOP], 1u);
            const unsigned tg = og / nx;
            if (og + 1u == (tg + 1u) * nx) xb_add(&bar[XB_TOPGEN], 1u);
            else XB_SPIN(xb_ld(&bar[XB_TOPGEN]) == tg, bar);
            __builtin_amdgcn_fence(__ATOMIC_ACQUIRE, "agent");
            xb_add(&bar[XB_XGEN(b.x)], 1u);
            asm volatile("s_waitcnt vmcnt(0)" ::: "memory");
        } else {
            XB_SPIN(xb_ld(&bar[XB_XGEN(b.x)]) == gen, bar);
            __builtin_amdgcn_fence(__ATOMIC_ACQUIRE, "agent");
            asm volatile("s_waitcnt vmcnt(0)" ::: "memory");
        }
    }
    __syncthreads();
}

#define PG8_LAS LAS
namespace pg8 {
constexpr int BM = 256, BK = 64, HALF = 128, HTB = HALF * BK * 2  , STAGE_BYTES = 8 * HTB, NXCD = 8, WGM = 4;

__host__ __device__ __forceinline__ int lds_byte(int r, int c) { const int st = (r >> 4) * 2 + (c >> 5), rr = r & 15, cc = c & 31, ob = rr * 64 + cc * 2; return st * 1024 + (ob ^ (((ob >> 9) & 1) << 5)); }
__host__ __device__ __forceinline__ void stage_rc(int b, int& R, int& C) { const int st = b / 1024, sb = b % 1024, swz = sb ^ (((sb >> 9) & 1) << 5); R = (st >> 1) * 16 + swz / 64; C = (st & 1) * 32 + (swz % 64) / 2; }
__host__ __device__ __forceinline__ int perm32(int rho) { const int n = rho >> 4, i = rho & 15; return 8 * (i >> 2) + 4 * n + (i & 3); }

struct Unit { int pm, pn; };
struct Gemm { const bf16_t* A; const bf16_t* Bt; int M, N, K; };

struct StaticOrder {
    int nM, nN, nwg, G, c;
    __host__ __device__ void init(int M, int N, int G_, int c_) { nM = M / BM; nN = N / BM; nwg = nM * nN; G = G_; c = c_; }
    __host__ __device__ bool next(int i, Unit& u) const {
        const long L = (long)i * G + c; if (L >= nwg) return false;
        int wgid = (int)L; { const int q = nwg / NXCD, r = nwg % NXCD, xcd = wgid % NXCD, off = wgid / NXCD; wgid = (xcd < r ? xcd * (q + 1) : r * (q + 1) + (xcd - r) * q) + off; }
        const int nig = WGM * nN, gid = wgid / nig, fm = gid * WGM, gsz = (nM - fm) < WGM ? (nM - fm) : WGM;
        u.pm = fm + ((wgid % nig) % gsz); u.pn = (wgid % nig) / gsz; return true;
    }
    __device__ __forceinline__ void a_ready(const Unit&) const {}
    __device__ __forceinline__ void done(const Unit&) const {}
};
struct TrimOrder {
    int G, c;
    __device__ bool next(int i, Unit& u) const {
        constexpr int NMl = 64, NNl = 74, NL = NMl * NNl, NC = 4 * 22;
        const long L = (long)i * G + c; if (L >= NL + NC) return false;
        if (L < NL) { int wgid = (int)L; { const int q = NL / NXCD, r = NL % NXCD, xcd = wgid % NXCD, off = wgid / NXCD; wgid = (xcd < r ? xcd * (q + 1) : r * (q + 1) + (xcd - r) * q) + off; }
            const int nig = WGM * NNl, gid = wgid / nig, fm = gid * WGM, gsz = (NMl - fm) < WGM ? (NMl - fm) : WGM;
            u.pm = fm + ((wgid % nig) % gsz); u.pn = (wgid % nig) / gsz; }
        else { const int e = (int)(L - NL), i2 = e % 22; u.pm = NMl + e / 22;
            u.pn = (i2 < 6) ? 4 + i2 : (i2 < 14) ? 16 + (i2 - 6) : (i2 < 20) ? 26 + (i2 - 14) : 40 + (i2 - 20); }
        return true;
    }
    __device__ __forceinline__ void a_ready(const Unit&) const {}
    __device__ __forceinline__ void done(const Unit&) const {}
};
__device__ __forceinline__ unsigned cvt_pk_bf16(float lo, float hi) { return ::pack2(lo, hi); }
template <class Epi, class Sched, bool ALIGN_EPI = false, bool SP2 = false>
__device__ __forceinline__ void gemm_phase(PG8_LAS unsigned char* lds, const Gemm g, const Sched& S, const Epi& E, int tid_in) {
    int tid_ = tid_in; asm volatile("" : "+v"(tid_)); const int tid = tid_, wid = __builtin_amdgcn_readfirstlane(tid >> 6), lane = tid & 63, wr = wid >> 2, wc = wid & 3, fr = lane & 15, fq = lane >> 4;
    const int K = g.K, nt = K / BK;
    unsigned voffA[2], voffB[2];
#pragma unroll
    for (int i = 0; i < 2; ++i) { int R, C; stage_rc(tid * 16 + i * 8192, R, C); const int Rb = Epi::PERM ? ((R & ~31) + perm32(R & 31)) : R;
        voffA[i] = (unsigned)(R * K + C) * 2u; voffB[i] = (unsigned)(Rb * K + C) * 2u; }
    const size_t kstep = (size_t)(BK * 2);
    const size_t hstep = (size_t)HALF * K * 2;
    const size_t tstep = 2 * hstep;
    const unsigned ldsw = (unsigned)wid * 1024u;
    const int aoff = lds_byte(wr * 64 + fr, fq * 8), boff = lds_byte(wc * 32 + fr, fq * 8);
#define PG8_SA(b, h) (((b) * 2 + (h)) * HTB)
#define PG8_SB(b, h) ((4 + (b) * 2 + (h)) * HTB)
#define PG8_STAGE(bufoff, gbase, voff) do { _Pragma("unroll") for (int _i = 0; _i < 2; ++_i) \
        __builtin_amdgcn_global_load_lds((const unsigned*)((const char*)(gbase) + (voff)[_i]), (PG8_LAS unsigned*)(lds + (bufoff) + ldsw + _i * 8192), 16, 0, 0); } while (0)
#define PG8_LDA(dst, b, h) do { _Pragma("unroll") for (int m = 0; m < 4; ++m) _Pragma("unroll") for (int k = 0; k < 2; ++k) dst[m][k] = *(const PG8_LAS bf16x8*)(lds + PG8_SA(b, h) + aoff + m * 2048 + k * 1024); } while (0)
#define PG8_LDB(dst, b, h) do { _Pragma("unroll") for (int n = 0; n < 2; ++n) _Pragma("unroll") for (int k = 0; k < 2; ++k) dst[n][k] = *(const PG8_LAS bf16x8*)(lds + PG8_SB(b, h) + boff + n * 2048 + k * 1024); } while (0)
#define PG8_MMA(ai, bj, At, Bt) do { __builtin_amdgcn_s_setprio(1); _Pragma("unroll") for (int m = 0; m < 4; ++m) _Pragma("unroll") for (int n = 0; n < 2; ++n) _Pragma("unroll") for (int k = 0; k < 2; ++k) \
        acc[ai][bj][m][n] = __builtin_amdgcn_mfma_f32_16x16x32_bf16(Bt[n][k], At[m][k], acc[ai][bj][m][n], 0, 0, 0); __builtin_amdgcn_s_setprio(0); } while (0)
#define PG8_WAIT_V(n) asm volatile("s_waitcnt vmcnt(" #n ")" ::: "memory")
#define PG8_WAIT_L(n) asm volatile("s_waitcnt lgkmcnt(" #n ")" ::: "memory")
#define PG8_BAR __builtin_amdgcn_s_barrier()
#define PG8_SCHED __builtin_amdgcn_sched_barrier(0)
    Unit cur, nxt; int ui = 0;
    if (!S.next(0, cur)) return;
    f32x4 acc[2][2][4][2];
#pragma unroll
    for (int a = 0; a < 2; ++a)
#pragma unroll
        for (int b = 0; b < 2; ++b)
#pragma unroll
            for (int m = 0; m < 4; ++m)
#pragma unroll
                for (int n = 0; n < 2; ++n) acc[a][b][m][n] = (f32x4){0.f, 0.f, 0.f, 0.f};
    bf16x8 At[4][2], B0[2][2], B1[2][2];
    const char* cA = (const char*)g.A + (size_t)cur.pm * tstep; const char* cB = (const char*)g.Bt + (size_t)cur.pn * tstep;
    S.a_ready(cur);
    if constexpr (SP2) {
        PG8_STAGE(PG8_SB(0, 0), cB, voffB); PG8_STAGE(PG8_SB(0, 1), cB + hstep, voffB); PG8_STAGE(PG8_SA(0, 0), cA, voffA); PG8_STAGE(PG8_SA(0, 1), cA + hstep, voffA);
        if (wr == 1) PG8_BAR;
        PG8_WAIT_V(2); PG8_BAR;
        PG8_STAGE(PG8_SB(1, 0), cB + kstep, voffB); PG8_STAGE(PG8_SA(1, 0), cA + kstep, voffA); PG8_STAGE(PG8_SB(1, 1), cB + hstep + kstep, voffB);
        PG8_WAIT_V(6); PG8_BAR;
    } else {
        PG8_STAGE(PG8_SB(0, 0), cB, voffB); PG8_STAGE(PG8_SA(0, 0), cA, voffA); PG8_STAGE(PG8_SB(0, 1), cB + hstep, voffB); PG8_STAGE(PG8_SA(0, 1), cA + hstep, voffA);
        if (wr == 1) PG8_BAR;
        PG8_WAIT_V(4); PG8_BAR;
        PG8_STAGE(PG8_SB(1, 0), cB + kstep, voffB); PG8_STAGE(PG8_SA(1, 0), cA + kstep, voffA); PG8_STAGE(PG8_SB(1, 1), cB + hstep + kstep, voffB);
        PG8_WAIT_V(6); PG8_BAR;
    }
    for (;;) {
        const bool has_next = S.next(ui + 1, nxt);
        const char* nA = has_next ? (const char*)g.A + (size_t)nxt.pm * tstep : cA; const char* nB = has_next ? (const char*)g.Bt + (size_t)nxt.pn * tstep : cB;
        for (int t = 0; t < nt; t += 2) {
            const bool last = (t == nt - 2);
            const char* a1 = cA + (size_t)(t + 1) * kstep;
            const char* a2 = last ? nA : cA + (size_t)(t + 2) * kstep; const char* b2 = last ? nB : cB + (size_t)(t + 2) * kstep;
            const char* a3 = a2 + kstep; const char* b3 = b2 + kstep;
            if constexpr (Epi::MIDK) { if (t > 0 && (t & 15) == 0) { unsigned mk2_ = ~0u; asm volatile("" : "+s"(mk2_)); const int l3_ = (int)__builtin_amdgcn_mbcnt_hi(mk2_, __builtin_amdgcn_mbcnt_lo(mk2_, 0u)); E.mid(acc, cur, t >> 4, wr, wc, l3_ & 15, l3_ >> 4); } }
            if (last && has_next) S.a_ready(nxt);
            if constexpr (SP2) {
            PG8_LDB(B0, 0, 0); PG8_LDB(B1, 0, 1); PG8_SCHED; PG8_LDA(At, 0, 0); PG8_STAGE(PG8_SA(1, 1), a1 + hstep, voffA);
            PG8_WAIT_V(8); PG8_WAIT_L(0); PG8_BAR; PG8_MMA(0, 0, At, B0); PG8_MMA(0, 1, At, B1); PG8_BAR; PG8_SCHED;
            PG8_LDA(At, 0, 1); PG8_STAGE(PG8_SB(0, 0), b2, voffB); PG8_STAGE(PG8_SB(0, 1), b2 + hstep, voffB); PG8_STAGE(PG8_SA(0, 0), a2, voffA);
            PG8_WAIT_V(8); PG8_WAIT_L(0); PG8_BAR; PG8_MMA(1, 0, At, B0); PG8_MMA(1, 1, At, B1); PG8_BAR; PG8_SCHED;
            PG8_LDB(B0, 1, 0); PG8_LDB(B1, 1, 1); PG8_SCHED; PG8_LDA(At, 1, 0); PG8_STAGE(PG8_SA(0, 1), a2 + hstep, voffA);
            PG8_WAIT_V(8); PG8_WAIT_L(0); PG8_BAR; PG8_MMA(0, 0, At, B0); PG8_MMA(0, 1, At, B1); PG8_BAR; PG8_SCHED;
            PG8_LDA(At, 1, 1); PG8_STAGE(PG8_SB(1, 0), b3, voffB); PG8_STAGE(PG8_SB(1, 1), b3 + hstep, voffB); PG8_STAGE(PG8_SA(1, 0), a3, voffA);
            PG8_WAIT_V(8); PG8_WAIT_L(0); PG8_BAR; PG8_MMA(1, 0, At, B0); PG8_MMA(1, 1, At, B1); PG8_BAR; PG8_SCHED;
            } else {
            PG8_LDB(B0, 0, 0); PG8_SCHED; PG8_LDA(At, 0, 0); PG8_STAGE(PG8_SA(1, 1), a1 + hstep, voffA);
            PG8_WAIT_L(8); PG8_BAR; PG8_WAIT_L(0); PG8_MMA(0, 0, At, B0); PG8_BAR; PG8_SCHED;
            PG8_LDB(B1, 0, 1); PG8_STAGE(PG8_SB(0, 0), b2, voffB);
            PG8_BAR; PG8_WAIT_L(0); PG8_MMA(0, 1, At, B1); PG8_BAR;
            PG8_LDA(At, 0, 1); PG8_STAGE(PG8_SA(0, 0), a2, voffA);
            PG8_BAR; PG8_WAIT_L(0); PG8_MMA(1, 0, At, B0); PG8_BAR; PG8_SCHED;
            PG8_STAGE(PG8_SB(0, 1), b2 + hstep, voffB);
            PG8_WAIT_V(6); PG8_BAR; PG8_MMA(1, 1, At, B1); PG8_BAR;
            PG8_LDB(B0, 1, 0); PG8_SCHED; PG8_LDA(At, 1, 0); PG8_STAGE(PG8_SA(0, 1), a2 + hstep, voffA);
            PG8_WAIT_L(8); PG8_BAR; PG8_WAIT_L(0); PG8_MMA(0, 0, At, B0); PG8_BAR; PG8_SCHED;
            PG8_LDB(B1, 1, 1); PG8_STAGE(PG8_SB(1, 0), b3, voffB);
            PG8_BAR; PG8_WAIT_L(0); PG8_MMA(0, 1, At, B1); PG8_BAR;
            PG8_LDA(At, 1, 1); PG8_STAGE(PG8_SA(1, 0), a3, voffA);
            PG8_BAR; PG8_WAIT_L(0); PG8_MMA(1, 0, At, B0); PG8_BAR; PG8_SCHED;
            PG8_STAGE(PG8_SB(1, 1), b3 + hstep, voffB);
            PG8_WAIT_V(6); PG8_BAR; PG8_MMA(1, 1, At, B1); PG8_BAR;
            }
        }
        if constexpr (ALIGN_EPI) { if (wr == 0) PG8_BAR; }
        if constexpr (!Epi::AFTER_DRAIN) { unsigned mk_ = ~0u; asm volatile("" : "+s"(mk_)); const int l2_ = (int)__builtin_amdgcn_mbcnt_hi(mk_, __builtin_amdgcn_mbcnt_lo(mk_, 0u));
            E(acc, cur, wr, wc, l2_ & 15, l2_ >> 4); S.done(cur); }
        if (!has_next) break;
#pragma unroll
        for (int a = 0; a < 2; ++a)
#pragma unroll
            for (int b = 0; b < 2; ++b)
#pragma unroll
                for (int m = 0; m < 4; ++m)
#pragma unroll
                    for (int n = 0; n < 2; ++n) acc[a][b][m][n] = (f32x4){0.f, 0.f, 0.f, 0.f};
        cur = nxt; cA = nA; cB = nB; ++ui;
        if constexpr (ALIGN_EPI) { if (wr == 1) PG8_BAR; }
    }
    PG8_WAIT_V(0);
    if constexpr (!ALIGN_EPI) { if (wr == 0) PG8_BAR; }
    PG8_BAR;
    if constexpr (Epi::AFTER_DRAIN) { E.fused(acc, cur, wr, wc, fr, fq, lds, wid, lane); S.done(cur); }
#undef PG8_SA
#undef PG8_SB
#undef PG8_STAGE
#undef PG8_LDA
#undef PG8_LDB
#undef PG8_MMA
#undef PG8_WAIT_V
#undef PG8_WAIT_L
#undef PG8_BAR
#undef PG8_SCHED
}
}
namespace pg8 {
__device__ __forceinline__ size_t gate_frag(int tile, int ai, int m, int bj, int wave, int lane) { return (size_t)tile * 65536 + (size_t)((((ai * 4 + m) * 2 + bj) * 8 + wave) * 512 + lane * 8); }
struct EpiInProj {
    static constexpr bool PERM = true, AFTER_DRAIN = false, MIDK = false;
    bf16_t* P1; unsigned char* G; float* DTR; float* GLR;
    __device__ __forceinline__ void operator()(const f32x4 (&acc)[2][2][4][2], const Unit& u, int wr, int wc, int fr, int fq) const {
        const int row0 = u.pm * BM + wr * 64 + fr;
        if (u.pn == 74) {
            if (wc < 2) {
                float* dst = (wc == 0) ? DTR : GLR;
#pragma unroll
                for (int ai = 0; ai < 2; ++ai)
#pragma unroll
                    for (int m = 0; m < 4; ++m) { float* rp = dst + (size_t)(row0 + ai * HALF + m * 16) * 32 + 8 * fq;
                        *(f32x4*)(rp) = acc[ai][0][m][0]; *(f32x4*)(rp + 4) = acc[ai][0][m][1]; }
            }
            return;
        }
        const bool gate = u.pn >= 42;
        const int colt = (gate ? (u.pn - 42) : u.pn) * BM;
        const int col0 = colt + wc * 32 + 8 * fq;
        if (gate) {
#pragma unroll
            for (int ai = 0; ai < 2; ++ai)
#pragma unroll
                for (int m = 0; m < 4; ++m) {
#pragma unroll
                    for (int bj = 0; bj < 2; ++bj) { unsigned char* rowp = G + gate_frag(u.pm * 32 + (u.pn - 42), ai, m, bj, wr * 4 + wc, fq * 16 + fr) - bj * HALF;
                        const f32x4 v0 = acc[ai][bj][m][0], v1 = acc[ai][bj][m][1]; u32x2 w; w.x = 0u; w.y = 0u;
#pragma unroll
                        for (int j = 0; j < 4; ++j) { w.x = __builtin_amdgcn_cvt_pk_u8_f32(__builtin_rintf(fmaxf(255.f * sigmf(v0[j]), 1.f)), j, w.x);
                            w.y = __builtin_amdgcn_cvt_pk_u8_f32(__builtin_rintf(fmaxf(255.f * sigmf(v1[j]), 1.f)), j, w.y); }
                        __builtin_nontemporal_store(w, (u32x2*)(rowp + bj * HALF)); } }
            return;
        }
#pragma unroll
        for (int ai = 0; ai < 2; ++ai)
#pragma unroll
            for (int m = 0; m < 4; ++m) { bf16_t* rowp = P1 + (size_t)(row0 + ai * HALF + m * 16) * P1W + col0;
#pragma unroll
                for (int bj = 0; bj < 2; ++bj) { const f32x4 v0 = acc[ai][bj][m][0], v1 = acc[ai][bj][m][1];
                    u32x4 w; w.x = cvt_pk_bf16(v0[0], v0[1]); w.y = cvt_pk_bf16(v0[2], v0[3]); w.z = cvt_pk_bf16(v1[0], v1[1]); w.w = cvt_pk_bf16(v1[2], v1[3]);
                    __builtin_nontemporal_store(w, (u32x4*)(rowp + bj * HALF)); } }
    }
};
struct EpiMerge {
    static constexpr bool PERM = true, AFTER_DRAIN = false, MIDK = true;
    const unsigned char* G; bf16_t* MB;
    __device__ __forceinline__ void mid(f32x4 (&acc)[2][2][4][2], const Unit& u, int nb  , int wr, int wc, int fr, int fq) const {
        const int row0 = u.pm * BM + wr * 64 + fr, col0 = u.pn * BM + wc * 32 + 8 * fq;
#pragma unroll
        for (int ai = 0; ai < 2; ++ai)
#pragma unroll
            for (int m = 0; m < 4; ++m) {
#pragma unroll
                for (int bj = 0; bj < 2; ++bj) { const unsigned char* gp = G + gate_frag(u.pm * 32 + (nb - 1) * 8 + u.pn, ai, m, bj, wr * 4 + wc, fq * 16 + fr);
                    const u32x2 a = __builtin_nontemporal_load((const u32x2*)gp), b = __builtin_nontemporal_load((const u32x2*)(gp + (size_t)8 * 65536));
                    f32x4& v0 = acc[ai][bj][m][0]; f32x4& v1 = acc[ai][bj][m][1];
#pragma unroll
                    for (int j = 0; j < 4; ++j) { v0[j] *= (float)((a.x >> (8 * j)) & 255u) * __builtin_amdgcn_rcpf((float)((b.x >> (8 * j)) & 255u));
                        v1[j] *= (float)((a.y >> (8 * j)) & 255u) * __builtin_amdgcn_rcpf((float)((b.y >> (8 * j)) & 255u)); } } }
    }
    __device__ __forceinline__ void operator()(const f32x4 (&acc)[2][2][4][2], const Unit& u, int wr, int wc, int fr, int fq) const {
        const int row0 = u.pm * BM + wr * 64 + fr, col0 = u.pn * BM + wc * 32 + 8 * fq;
#pragma unroll
        for (int ai = 0; ai < 2; ++ai)
#pragma unroll
            for (int m = 0; m < 4; ++m) { const size_t r = (size_t)(row0 + ai * HALF + m * 16);
#pragma unroll
                for (int bj = 0; bj < 2; ++bj) { const int c = col0 + bj * HALF;
                    const u32x2 gw = __builtin_nontemporal_load((const u32x2*)(G + gate_frag(u.pm * 32 + 24 + u.pn, ai, m, bj, wr * 4 + wc, fq * 16 + fr)));
                    f32x4 v0 = acc[ai][bj][m][0], v1 = acc[ai][bj][m][1];
#pragma unroll
                    for (int j = 0; j < 4; ++j) { v0[j] *= (float)((gw.x >> (8 * j)) & 255u) * (1.f / 255.f); v1[j] *= (float)((gw.y >> (8 * j)) & 255u) * (1.f / 255.f); }
                    u32x4 w; w.x = cvt_pk_bf16(v0[0], v0[1]); w.y = cvt_pk_bf16(v0[2], v0[3]); w.z = cvt_pk_bf16(v1[0], v1[1]); w.w = cvt_pk_bf16(v1[2], v1[3]);
                    __builtin_nontemporal_store(w, (u32x4*)(MB + r * DM + c)); } }
    }
};
struct EpiResid {
    static constexpr bool PERM = false, AFTER_DRAIN = false, MIDK = false;
    const float* xi; float* xo; const float* ci; float* co; const float* mod;   int which;
    __device__ __forceinline__ void operator()(const f32x4 (&acc)[2][2][4][2], const Unit& u, int wr, int wc, int fr, int fq) const {
        const int row0 = u.pm * BM + wr * 64 + fr, col0 = u.pn * BM + wc * 32 + 4 * fq;
#pragma unroll
        for (int ai = 0; ai < 2; ++ai)
#pragma unroll
            for (int m = 0; m < 4; ++m) { const int r = row0 + ai * HALF + m * 16;
                const bool lat = r < RX; const int j = lat ? (r >> 12) : 4;
                const float* ip = lat ? xi + (size_t)r * DM : ci + (size_t)(r - RX) * DM; float* op = lat ? xo + (size_t)r * DM : co + (size_t)(r - RX) * DM;
                const float* gp = mod + ((size_t)j * 6 + which) * DM;
#pragma unroll
                for (int bj = 0; bj < 2; ++bj)
#pragma unroll
                    for (int n = 0; n < 2; ++n) { const int c = col0 + bj * HALF + n * 16;
                        const f32x4 g = *(const f32x4*)(gp + c); const f32x4 x = *(const f32x4*)(ip + c);
                        *(f32x4*)(op + c) = x + g * acc[ai][bj][m][n]; } }
    }
};
struct EpiDelta {
    static constexpr bool PERM = true, AFTER_DRAIN = false, MIDK = false;
    bf16_t* D; const float* mod;   int which;
    __device__ __forceinline__ void operator()(const f32x4 (&acc)[2][2][4][2], const Unit& u, int wr, int wc, int fr, int fq) const {
        const int row0 = u.pm * BM + wr * 64 + fr, col0 = u.pn * BM + wc * 32 + 8 * fq;
#pragma unroll
        for (int ai = 0; ai < 2; ++ai)
#pragma unroll
            for (int m = 0; m < 4; ++m) { const int r = row0 + ai * HALF + m * 16; const int j = (r < RX) ? (r >> 12) : 4;
                const float* gp = mod + ((size_t)j * 6 + which) * DM;
#pragma unroll
                for (int bj = 0; bj < 2; ++bj) { const int c = col0 + bj * HALF; const f32x4 g0 = *(const f32x4*)(gp + c), g1 = *(const f32x4*)(gp + c + 4);
                    const f32x4 v0 = g0 * acc[ai][bj][m][0], v1 = g1 * acc[ai][bj][m][1];
                    u32x4 w; w.x = cvt_pk_bf16(v0[0], v0[1]); w.y = cvt_pk_bf16(v0[2], v0[3]); w.z = cvt_pk_bf16(v1[0], v1[1]); w.w = cvt_pk_bf16(v1[2], v1[3]);
                    __builtin_nontemporal_store(w, (u32x4*)(D + (size_t)r * DM + c)); } }
    }
};
struct EpiBf16P {
    static constexpr bool PERM = true, AFTER_DRAIN = false, MIDK = false;
    bf16_t* O; int ldc;
    __device__ __forceinline__ void operator()(const f32x4 (&acc)[2][2][4][2], const Unit& u, int wr, int wc, int fr, int fq) const {
        const int row0 = u.pm * BM + wr * 64 + fr, col0 = u.pn * BM + wc * 32 + 8 * fq;
#pragma unroll
        for (int ai = 0; ai < 2; ++ai)
#pragma unroll
            for (int m = 0; m < 4; ++m) { bf16_t* rowp = O + (size_t)(row0 + ai * HALF + m * 16) * ldc + col0;
#pragma unroll
                for (int bj = 0; bj < 2; ++bj) { const f32x4 v0 = acc[ai][bj][m][0], v1 = acc[ai][bj][m][1];
                    u32x4 w; w.x = cvt_pk_bf16(v0[0], v0[1]); w.y = cvt_pk_bf16(v0[2], v0[3]); w.z = cvt_pk_bf16(v1[0], v1[1]); w.w = cvt_pk_bf16(v1[2], v1[3]);
                    __builtin_nontemporal_store(w, (u32x4*)(rowp + bj * HALF)); } }
    }
};
struct EpiF32 {
    static constexpr bool PERM = false, AFTER_DRAIN = false, MIDK = false;
    float* C; int ldc;
    __device__ __forceinline__ void operator()(const f32x4 (&acc)[2][2][4][2], const Unit& u, int wr, int wc, int fr, int fq) const {
        const int row0 = u.pm * BM + wr * 64 + fr, col0 = u.pn * BM + wc * 32 + 4 * fq;
#pragma unroll
        for (int ai = 0; ai < 2; ++ai)
#pragma unroll
            for (int m = 0; m < 4; ++m) { float* rowp = C + (size_t)(row0 + ai * HALF + m * 16) * ldc + col0;
#pragma unroll
                for (int bj = 0; bj < 2; ++bj)
#pragma unroll
                    for (int n = 0; n < 2; ++n) *(f32x4*)(rowp + bj * HALF + n * 16) = acc[ai][bj][m][n]; }
    }
};
}
struct Params { const float* in[31]; float* out; unsigned char* ws; int ph_lo, ph_hi; };
enum { I_X = 0, I_C, I_CTX, I_CCTX, I_WADA, I_BADA, I_GN1, I_GN2, I_WIN, I_CONVW, I_CONVB, I_ALOG, I_DTB, I_SSDD, I_SSDNG, I_NAQN, I_NAKN, I_RPB,
       I_GLAWG, I_GLABG, I_GLANG, I_SWAQN, I_SWAKN, I_SINK, I_WBR, I_WOUT, I_PWQ, I_PK1, I_PK2, I_PU, I_PV };
struct Frame {
    const float* const* in; float* out; unsigned char* ws; LAS unsigned char* lds; unsigned char* ldsg;
    int tid, lane, wave, G, bid;
    __device__ __forceinline__ unsigned* ctl() const { return (unsigned*)(ws + WS_CTL); }
    __device__ __forceinline__ float* mod() const { return (float*)(ws + WS_MOD); }
    __device__ __forceinline__ bf16_t* win() const { return (bf16_t*)(ws + WS_WIN); }
    __device__ __forceinline__ bf16_t* wbr() const { return (bf16_t*)(ws + WS_WBR); }
    __device__ __forceinline__ bf16_t* wout() const { return (bf16_t*)(ws + WS_WOUT); }
    __device__ __forceinline__ bf16_t* wq() const { return (bf16_t*)(ws + WS_WQ); }
    __device__ __forceinline__ bf16_t* hn() const { return (bf16_t*)(ws + WS_HN); }
    __device__ __forceinline__ bf16_t* p1() const { return (bf16_t*)(ws + WS_P1); }
    __device__ __forceinline__ bf16_t* g() const { return (bf16_t*)(ws + WS_G); }
    __device__ __forceinline__ bf16_t* ys() const { return (bf16_t*)(ws + WS_YS); }
    __device__ __forceinline__ bf16_t* og() const { return (bf16_t*)(ws + WS_OG); }
    __device__ __forceinline__ bf16_t* outs() const { return (bf16_t*)(ws + WS_OUTS); }
    __device__ __forceinline__ bf16_t* mb() const { return (bf16_t*)(ws + WS_MB); }
    __device__ __forceinline__ float* dtr() const { return (float*)(ws + WS_DTR); }
    __device__ __forceinline__ float* glr() const { return (float*)(ws + WS_GLR); }
    __device__ __forceinline__ float* dt() const { return (float*)(ws + WS_DT); }
    __device__ __forceinline__ float* ctxs() const { return (float*)(ws + WS_CTXS); }
    __device__ __forceinline__ float* mp() const { return (float*)(ws + WS_MP); }
    __device__ __forceinline__ float* qp() const { return (float*)(ws + WS_QP); }
    __device__ __forceinline__ float* gate() const { return (float*)(ws + WS_GATE); }
    __device__ __forceinline__ int* idx() const { return (int*)(ws + WS_IDX); }
    __device__ __forceinline__ bf16_t* vtna() const { return (bf16_t*)(ws + WS_VTNA); }
    __device__ __forceinline__ bf16_t* vtsw() const { return (bf16_t*)(ws + WS_VTSW); }
    __device__ __forceinline__ float* gcum() const { return (float*)(ws + WS_GCUM); }
    __device__ __forceinline__ float* csum() const { return (float*)(ws + WS_CSUM); }
    int wave0; const float* const* in0; unsigned char* ws0;
    __device__ __forceinline__ void relaunder() { size_t z = 0; asm volatile("" : "+s"(z)); ws = ws0 + z; }
    __device__ __forceinline__ void init_ids() { wave0 = __builtin_amdgcn_readfirstlane((int)threadIdx.x >> 6); }
    __device__ __forceinline__ void refresh(unsigned char* w) { unsigned mk = ~0u; asm volatile("" : "+s"(mk)); int ln = (int)__builtin_amdgcn_mbcnt_hi(mk, __builtin_amdgcn_mbcnt_lo(mk, 0u));
        int wv = wave0; asm volatile("" : "+s"(wv)); lane = ln; wave = wv; tid = wv * 64 + ln;
        ws0 = w; size_t z = 0; asm volatile("" : "+s"(z)); ws = w + z; }
};
__device__ __forceinline__ int next_unit(Frame& F, int qslot) {
    volatile LAS int* w = (volatile LAS int*)(F.lds + 147440);
    __syncthreads();
    if (F.tid == 0) *w = (int)__hip_atomic_fetch_add(F.ctl() + CW_Q + 64 * qslot, 1u, __ATOMIC_RELAXED, __HIP_MEMORY_SCOPE_AGENT);
    __syncthreads();
    return __builtin_amdgcn_readfirstlane(*w);
}

__device__ __forceinline__ void phase_mod(Frame& F) {
    float* sc = (float*)F.ldsg;
    float* red = (float*)(F.ldsg + 40960);
    for (int i = F.tid; i < 5 * DM; i += 512) { const int j = i / DM, k = i % DM; const float v = (j < 4) ? F.in[I_C][j * DM + k] : F.in[I_CCTX][k]; sc[i] = siluf(v); }
    __syncthreads();
    const int kq = F.tid >> 5, cq = F.tid & 31;
    for (int u = F.bid; u < DEPTH * 96; u += F.G) {
        const int l = u / 96, cb = u % 96, col = cb * 128 + cq * 4;
        const float* w = F.in[I_WADA] + (size_t)l * DM * (6 * DM) + col;
        f32x4 a[5];
#pragma unroll
        for (int j = 0; j < 5; ++j) a[j] = (f32x4){0.f, 0.f, 0.f, 0.f};
#pragma unroll 4
        for (int k = kq; k < DM; k += 16) { const f32x4 wv = *(const f32x4*)(w + (size_t)k * (6 * DM));
#pragma unroll
            for (int j = 0; j < 5; ++j) a[j] += sc[j * DM + k] * wv; }
#pragma unroll
        for (int j = 0; j < 5; ++j) *(f32x4*)(red + (kq * 5 + j) * 128 + cq * 4) = a[j];
        __syncthreads();
        for (int o = F.tid; o < 5 * 128; o += 512) { const int j = o >> 7, c = o & 127; float s = 0.f;
#pragma unroll
            for (int q = 0; q < 16; ++q) s += red[(q * 5 + j) * 128 + c];
            F.mod()[((size_t)(l * 5 + j)) * (6 * DM) + cb * 128 + c] = s + F.in[I_BADA][(size_t)l * 6 * DM + cb * 128 + c]; }
        __syncthreads();
    }
}

__device__ __forceinline__ int win_orig_col(int n) {
    if (n < 3072) return n; if (n < 9216) return n + 32; if (n < 18944) return n + 64; if (n < 18976) return n - 18944 + 3072; if (n < 19008) return n - 18976 + 9248; return -1;
}
struct CvtTile { const float* src; bf16_t* dst; int ldsrc, K, k0, n0; bool remap; };
__device__ __forceinline__ CvtTile wcvt_desc(Frame& F, int l, int u) {
    constexpr int T_IN = 32 * (INP / 128), T_BR = 4 * 16 * 16, T_O = 32 * 16;
    CvtTile t;
    if (u < T_IN) { const int kt = u % 32, nt = u / 32; t = CvtTile{F.in[I_WIN] + (size_t)l * DM * INW, F.win(), INW, DM, kt * 64, nt * 128, true}; }
    else if (u < T_IN + T_BR) { const int v = u - T_IN, br = v >> 8, w = v & 255, kt = w % 16, nt = w / 16;
        t = CvtTile{F.in[I_WBR] + ((size_t)l * 4 + br) * 1024 * DM, F.wbr() + (size_t)br * 1024, DM, 4096, kt * 64, nt * 128, false}; }
    else if (u < T_IN + T_BR + T_O) { const int v = u - T_IN - T_BR, kt = v % 32, nt = v / 32; t = CvtTile{F.in[I_WOUT] + (size_t)l * DM * DM, F.wout(), DM, DM, kt * 64, nt * 128, false}; }
    else { const int v = u - T_IN - T_BR - T_O, kt = v % 32, nt = v / 32; t = CvtTile{F.in[I_PWQ] + (size_t)l * DM * DM, F.wq(), DM, DM, kt * 64, nt * 128, false}; }
    return t;
}
__device__ __forceinline__ void cvt_load(Frame& F, const CvtTile& t, f32x4 (&v)[4]) {
#pragma unroll
    for (int i = 0; i < 4; ++i) { const int e = F.tid + i * 512, kk = e >> 5, n4 = (e & 31) * 4; const int oc = t.remap ? win_orig_col(t.n0 + n4) : (t.n0 + n4);
        const int occ = oc >= 0 ? oc : 0; const f32x4 x = *(const f32x4*)(t.src + (size_t)(t.k0 + kk) * t.ldsrc + occ);
        v[i] = (oc >= 0) ? x : (f32x4){0.f, 0.f, 0.f, 0.f}; }
}
__device__ __forceinline__ void cvt_store(Frame& F, const CvtTile& t, const f32x4 (&v)[4]) {
    float* s = (float*)F.ldsg;
    __syncthreads();
#pragma unroll
    for (int i = 0; i < 4; ++i) { const int e = F.tid + i * 512, kk = e >> 5, n4 = (e & 31) * 4; *(f32x4*)(s + kk * 132 + n4) = v[i]; }
    __syncthreads();
#pragma unroll
    for (int i = 0; i < 2; ++i) { const int e = F.tid + i * 512, nn = e & 127, kc = (e >> 7) * 8;
        u32x4 w; w.x = pack2(s[(kc + 0) * 132 + nn], s[(kc + 1) * 132 + nn]); w.y = pack2(s[(kc + 2) * 132 + nn], s[(kc + 3) * 132 + nn]);
        w.z = pack2(s[(kc + 4) * 132 + nn], s[(kc + 5) * 132 + nn]); w.w = pack2(s[(kc + 6) * 132 + nn], s[(kc + 7) * 132 + nn]);
        *(u32x4*)(t.dst + (size_t)(t.n0 + nn) * t.K + t.k0 + kc) = w; }
}
__device__ __forceinline__ void phase_wcvt(Frame& F, int l) {
    constexpr int NT = 32 * (INP / 128) + 4 * 16 * 16 + 32 * 16 + 32 * 16;
    f32x4 va[4], vb[4];
    int u = F.bid;
    if (u >= NT) { __syncthreads(); return; }
    { const CvtTile t0 = wcvt_desc(F, l, u); cvt_load(F, t0, va); }
#pragma unroll 1
    for (; u < NT; u += 2 * F.G) {
        const int u1 = u + F.G, u2 = u + 2 * F.G;
        { const CvtTile tb = wcvt_desc(F, l, min(u1, NT - 1)); cvt_load(F, tb, vb); }
        { const CvtTile ta = wcvt_desc(F, l, u); cvt_store(F, ta, va); }
        { const CvtTile tc = wcvt_desc(F, l, min(u2, NT - 1)); cvt_load(F, tc, va); }
        if (u1 < NT) { const CvtTile tb = wcvt_desc(F, l, u1); cvt_store(F, tb, vb); }
    }
    __syncthreads();
}

__device__ __forceinline__ void phase_norm(Frame& F, int l, int which, const float* xs, const float* cs, int nrows, const bf16_t* delta = nullptr) {
    const float* g = F.in[which ? I_GN2 : I_GN1] + (size_t)l * DM;
    for (int row = F.bid * 8 + F.wave; row < nrows; row += F.G * 8) {
        const bool lat = row < RX; const int j = lat ? (row >> 12) : 4;
        const float* src = lat ? xs + (size_t)row * DM : cs + (size_t)(row - RX) * DM;
        const float* sh = F.mod() + ((size_t)(l * 5 + j) * 6 + which * 3 + 0) * DM; const float* sc = sh + DM;
        f32x4 v[8]; float ss = 0.f;
#pragma unroll
        for (int i = 0; i < 8; ++i) { v[i] = *(const f32x4*)(src + i * 256 + F.lane * 4);
            if (which == 1) { const u32x2 dw = *(const u32x2*)(delta + (size_t)row * DM + i * 256 + F.lane * 4); v[i][0] += lo2f(dw.x); v[i][1] += hi2f(dw.x); v[i][2] += lo2f(dw.y); v[i][3] += hi2f(dw.y); }
            ss += v[i][0] * v[i][0] + v[i][1] * v[i][1] + v[i][2] * v[i][2] + v[i][3] * v[i][3]; }
        ss = wsum(ss); const float r = rsqrtf(ss * (1.f / DM) + EPS);
#pragma unroll
        for (int i = 0; i < 8; ++i) { const int c = i * 256 + F.lane * 4; const f32x4 gg = *(const f32x4*)(g + c), s1 = *(const f32x4*)(sc + c), s0 = *(const f32x4*)(sh + c);
            const f32x4 h = v[i] * r * gg * (1.f + s1) + s0;
            u32x2 w; w.x = pack2(h[0], h[1]); w.y = pack2(h[2], h[3]); *(u32x2*)(F.hn() + (size_t)row * DM + c) = w;
            if (which == 1) {
                float am = fmaxf(fmaxf(fabsf(h[0]), fabsf(h[1])), fmaxf(fabsf(h[2]), fabsf(h[3])));
                am = fmaxf(am, xsw<16>(am)); am = fmaxf(am, xsw<8>(am)); am = fmaxf(am, xsw<4>(am)); am = fmaxf(am, xsw<2>(am)); am = fmaxf(am, xsw<1>(am));
                const float qs = (am > 0.f) ? 127.f / am : 0.f;
                const int q0 = (int)__builtin_rintf(h[0] * qs), q1 = (int)__builtin_rintf(h[1] * qs), q2 = (int)__builtin_rintf(h[2] * qs), q3 = (int)__builtin_rintf(h[3] * qs);
                unsigned char* gbq = (unsigned char*)F.g();
                *(unsigned*)(gbq + PE_HQ + (size_t)row * DM + c) = (unsigned)(q0 & 255) | ((unsigned)(q1 & 255) << 8) | ((unsigned)(q2 & 255) << 16) | ((unsigned)q3 << 24);
                if ((F.lane & 31) == 0) *(float*)(gbq + PE_HS + ((size_t)row * 16 + i * 2 + (F.lane >> 5)) * 4) = am * (1.f / 127.f); } }
    }
}

__device__ __forceinline__ void phase_prep(Frame& F, int l, bool dry = false) {
    const float* cw = F.in[I_CONVW] + (size_t)l * 5 * 2048; const float* cb = F.in[I_CONVB] + (size_t)l * 2048;
    bf16_t* xact = F.hn();
    const int v = F.tid >> 3, li = F.tid & 7;
    float* rct = (float*)(F.ldsg + 131072); float* rst = rct + 1024;
    __syncthreads();
    for (int e = F.tid; e < 1024; e += 512) { const int pp = e >> 4, f = e & 15; const float inv = expf(-(float)f * (9.210340371976184f / 16.f)); float sn, cs; sincosf((float)pp * inv, &sn, &cs); rct[e] = cs; rst[e] = sn; }
    __syncthreads();
    float wt[5][8], bias[8];
    { const int c = (F.tid & 255) * 8;
#pragma unroll
      for (int e = 0; e < 8; ++e) bias[e] = cb[c + e];
#pragma unroll
      for (int j = 0; j < 5; ++j)
#pragma unroll
        for (int e = 0; e < 8; ++e) wt[j][e] = cw[j * 2048 + c + e]; }
    for (int q4 = F.bid; q4 < MR / 4; q4 += F.G) {
        const int row0 = q4 * 4; const bool lat = row0 < RX; const int pos0 = lat ? (row0 & 4095) : ((row0 - RX) & 255), n = lat ? SEQ : LCTX;
        if (F.tid < 256) {
            const int c = F.tid * 8; u32x4 w[8];
#pragma unroll
            for (int j = 0; j < 8; ++j) { const int pq = pos0 + j - 2; w[j] = (pq >= 0 && pq < n) ? *(const u32x4*)(F.p1() + (size_t)(row0 + j - 2) * P1W + C_XBC + c) : (u32x4){0u, 0u, 0u, 0u}; }
#pragma unroll
            for (int rr = 0; rr < 4; ++rr) { float a[8];
#pragma unroll
                for (int e = 0; e < 8; ++e) a[e] = bias[e];
#pragma unroll
                for (int j = 0; j < 5; ++j) { const u32x4 ww = w[rr + j];
                    a[0] += lo2f(ww.x) * wt[j][0]; a[1] += hi2f(ww.x) * wt[j][1]; a[2] += lo2f(ww.y) * wt[j][2]; a[3] += hi2f(ww.y) * wt[j][3];
                    a[4] += lo2f(ww.z) * wt[j][4]; a[5] += hi2f(ww.z) * wt[j][5]; a[6] += lo2f(ww.w) * wt[j][6]; a[7] += hi2f(ww.w) * wt[j][7]; }
                u32x4 o; o.x = pack2(siluf(a[0]), siluf(a[1])); o.y = pack2(siluf(a[2]), siluf(a[3])); o.z = pack2(siluf(a[4]), siluf(a[5])); o.w = pack2(siluf(a[6]), siluf(a[7]));
                *(u32x4*)(xact + (size_t)(row0 + rr) * 2048 + c) = o; }
        }
        if (F.tid < 128) { const int rr = F.tid >> 5, c = F.tid & 31; const float x = F.dtr()[(size_t)(row0 + rr) * 32 + c] + F.in[I_DTB][l * 32 + c];
            F.dt()[(size_t)(row0 + rr) * 32 + c] = fmaxf(x, 0.f) + 0.6931471805599453f * __builtin_amdgcn_logf(1.f + __builtin_amdgcn_exp2f(-1.4426950408889634f * fabsf(x))); }
        {
            const bool act = v < 52; int coff; const float* gn; float scl = 1.f; bool rope = false;
            if (v < 16) { coff = C_NA + v * 64; gn = F.in[I_NAQN] + l * 64; scl = 0.125f; }
            else if (v < 32) { coff = C_NA + 1024 + (v - 16) * 64; gn = F.in[I_NAKN] + l * 64; }
            else if (v < 48) { coff = C_SQ + (v - 32) * 64; gn = F.in[I_SWAQN] + l * 64; scl = 0.125f; rope = lat; }
            else { coff = C_SK + ((v - 48) & 3) * 64; gn = F.in[I_SWAKN] + l * 64; rope = lat; }
            float gw[8];
#pragma unroll
            for (int e = 0; e < 8; ++e) gw[e] = gn[li * 8 + e];
            u32x4 wv[4];
#pragma unroll
            for (int rr = 0; rr < 4; ++rr) wv[rr] = act ? *(const u32x4*)(F.p1() + (size_t)(row0 + rr) * P1W + coff + li * 8) : (u32x4){0u, 0u, 0u, 0u};
#pragma unroll
            for (int rr = 0; rr < 4; ++rr) { const u32x4 w = wv[rr]; const int pos = pos0 + rr;
                float x[8] = {lo2f(w.x), hi2f(w.x), lo2f(w.y), hi2f(w.y), lo2f(w.z), hi2f(w.z), lo2f(w.w), hi2f(w.w)};
                float ss = 0.f;
#pragma unroll
                for (int e = 0; e < 8; ++e) ss += x[e] * x[e];
                ss += xsw<1>(ss); ss += xsw<2>(ss); ss += xsw<4>(ss);
                const float r = rsqrtf(ss * (1.f / 64.f) + EPS);
#pragma unroll
                for (int e = 0; e < 8; ++e) x[e] = x[e] * r * gw[e];
                float y[8];
#pragma unroll
                for (int e = 0; e < 8; ++e) y[e] = xsw<2>(x[e]);
                if (dry) { asm volatile("" :: "v"(x[0]), "v"(x[7]), "v"(y[3])); }
                if (rope) {
                    const int pc = (li < 4) ? (pos >> 6) : (pos & 63);
#pragma unroll
                    for (int e = 0; e < 8; ++e) { const int f = (li & 1) * 8 + e; const float cs = rct[pc * 16 + f], sn = rst[pc * 16 + f];
                        x[e] = (li & 2) ? (y[e] * sn + x[e] * cs) : (x[e] * cs - y[e] * sn); }
                }
                if (act && !dry) { u32x4 o; o.x = pack2(x[0] * scl, x[1] * scl); o.y = pack2(x[2] * scl, x[3] * scl); o.z = pack2(x[4] * scl, x[5] * scl); o.w = pack2(x[6] * scl, x[7] * scl);
                    *(u32x4*)(F.p1() + (size_t)(row0 + rr) * P1W + coff + li * 8) = o; }
            }
        }
    }
    for (int u = F.bid; u < 2 * (MR / 64); u += F.G) {
        const int dir = u & 1, rb = u >> 1, rowb = rb * 64;
        float* sgl = (float*)F.ldsg;
        __syncthreads();
        float* sdt = sgl + 1024;
        for (int e = F.tid; e < 1024; e += 512) { sgl[e] = F.glr()[(size_t)(rowb + (e >> 4)) * 32 + dir * 16 + (e & 15)]; sdt[e] = F.dtr()[(size_t)(rowb + (e >> 4)) * 32 + dir * 16 + (e & 15)]; }
        float wg[16];
#pragma unroll
        for (int k = 0; k < 16; ++k) wg[k] = F.in[I_GLAWG][(((size_t)l * 2 + dir) * 16 + k) * 512 + F.tid];
        const float bg = F.in[I_GLABG][((size_t)l * 2 + dir) * 512 + F.tid];
        __syncthreads();
#pragma unroll
        for (int hh = 0; hh < 2; ++hh) { const int head = F.wave * 2 + hh, r = dir ? 63 - F.lane : F.lane;
            const float a = -expf(F.in[I_ALOG][l * 32 + dir * 16 + head]), x = sdt[r * 16 + head] + F.in[I_DTB][l * 32 + dir * 16 + head];
            const float dtv = fmaxf(x, 0.f) + 0.6931471805599453f * __builtin_amdgcn_logf(1.f + __builtin_amdgcn_exp2f(-1.4426950408889634f * fabsf(x)));
            float tot = dtv * a, pre = tot, t;
            t = xsw<1>(tot); pre += (F.lane & 1) ? t : 0.f; tot += t;   t = xsw<2>(tot); pre += (F.lane & 2) ? t : 0.f; tot += t;   t = xsw<4>(tot); pre += (F.lane & 4) ? t : 0.f; tot += t;
            t = xsw<8>(tot); pre += (F.lane & 8) ? t : 0.f; tot += t;   t = xsw<16>(tot); pre += (F.lane & 16) ? t : 0.f; tot += t;   t = xsw<32>(tot); pre += (F.lane & 32) ? t : 0.f; tot += t;
            F.csum()[((size_t)dir * MR + rowb + r) * 16 + head] = pre; }
        float run = 0.f; float* gout = F.gcum() + ((size_t)dir * MR + rowb) * 512 + F.tid;
#pragma unroll 4
        for (int i = 0; i < 64; ++i) { const int r = dir ? 63 - i : i; float lg = bg;
            const f32x4 g0 = *(const f32x4*)(sgl + r * 16), g1 = *(const f32x4*)(sgl + r * 16 + 4), g2 = *(const f32x4*)(sgl + r * 16 + 8), g3 = *(const f32x4*)(sgl + r * 16 + 12);
            lg += g0[0] * wg[0] + g0[1] * wg[1] + g0[2] * wg[2] + g0[3] * wg[3]; lg += g1[0] * wg[4] + g1[1] * wg[5] + g1[2] * wg[6] + g1[3] * wg[7];
            lg += g2[0] * wg[8] + g2[1] * wg[9] + g2[2] * wg[10] + g2[3] * wg[11]; lg += g3[0] * wg[12] + g3[1] * wg[13] + g3[2] * wg[14] + g3[3] * wg[15];
            const float ls = fminf(lg, 0.f) - 0.6931471805599453f * __builtin_amdgcn_logf(1.f + __builtin_amdgcn_exp2f(-1.4426950408889634f * fabsf(lg)));
            run += ls * (1.f / 16.f); gout[(size_t)r * 512] = run; }
    }
    __syncthreads();
    for (int tile = F.bid; tile < MR / 32; tile += F.G) {
    {
        bf16_t* sv = (bf16_t*)F.ldsg;
        const int row0 = tile * 32; const bool lat = row0 < RX; const int b = lat ? (row0 >> 12) : ((row0 - RX) >> 8); const int tok0 = lat ? (row0 & 4095) : (SEQ + ((row0 - RX) & 255));
        __syncthreads();
        for (int e = F.tid; e < 32 * 160; e += 512) { const int r = e / 160, ch = e % 160; const int col = (ch < 128) ? (C_NA + 2048 + ch * 8) : (C_SV + (ch - 128) * 8);
            const u32x4 w = *(const u32x4*)(F.p1() + (size_t)(row0 + r) * P1W + col); unsigned* d = (unsigned*)(sv + r * 1282 + ch * 8); d[0] = w.x; d[1] = w.y; d[2] = w.z; d[3] = w.w; }
        __syncthreads();
        for (int e = F.tid; e < 1280 * 4; e += 512) { const int hd = e >> 2, q = e & 3;
            u32x4 o; unsigned short t8[8];
#pragma unroll
            for (int i = 0; i < 8; ++i) t8[i] = sv[(q * 8 + i) * 1282 + hd];
            o.x = t8[0] | ((unsigned)t8[1] << 16); o.y = t8[2] | ((unsigned)t8[3] << 16); o.z = t8[4] | ((unsigned)t8[5] << 16); o.w = t8[6] | ((unsigned)t8[7] << 16);
            const int d = hd & 63, tok = tok0 + q * 8, tile16 = tok >> 4, g0 = (tok & 15) >> 2;
            bf16_t* base = (hd < 1024) ? F.vtna() + (size_t)(b * 16 + (hd >> 6)) * 64 * VTS : F.vtsw() + (size_t)(b * 4 + ((hd - 1024) >> 6)) * 64 * VTS;
            *(u32x4*)(base + (((size_t)tile16 * 4 + (d >> 4)) * 16 + (d & 15)) * 16 + g0 * 4) = o; }
        __syncthreads();
    }
    }
}
#ifdef DBG_NAIVE
__global__ void __launch_bounds__(256) ssd_naive(Params P, int l) {
    Frame F; F.in = P.in; F.out = P.out; F.ws = P.ws; const int gid = blockIdx.x * 256 + threadIdx.x; if (gid >= 8192) return;
    const int p = gid & 63, dir = (gid >> 6) & 1, h = (gid >> 7) & 15, b = gid >> 11, grp = h >> 2;
    const bf16_t* xact = F.hn(); bf16_t* yout = F.ys() + (size_t)dir * MR * 1024;
    const float a = -expf(F.in[I_ALOG][l * 32 + dir * 16 + h]);
    float st[128];
#pragma unroll
    for (int n = 0; n < 128; ++n) st[n] = 0.f;
    for (int seg = 0; seg < 2; ++seg) { const int nn = seg ? SEQ : LCTX, base = seg ? b * SEQ : RX + b * LCTX;
        for (int i = 0; i < nn; ++i) { const int ps = dir ? (nn - 1 - i) : i; const size_t row = (size_t)(base + ps);
            const float dtv = F.dt()[row * 32 + dir * 16 + h], dec = expf(dtv * a), xv = bf2f(xact[row * 2048 + h * 64 + p]) * dtv; float y = 0.f;
#pragma unroll
            for (int n = 0; n < 128; ++n) { const float Bn = bf2f(xact[row * 2048 + 1024 + grp * 128 + n]), Cn = bf2f(xact[row * 2048 + 1536 + grp * 128 + n]); st[n] = dec * st[n] + xv * Bn; y += Cn * st[n]; }
            yout[row * 1024 + h * 64 + p] = f2bf(y); } }
}
__global__ void __launch_bounds__(256) gla_naive(Params P, int l) {
    Frame F; F.in = P.in; F.out = P.out; F.ws = P.ws; const int gid = blockIdx.x * 256 + threadIdx.x; if (gid >= 8192) return;
    const int v = gid & 255, dir = (gid >> 8) & 1, h = (gid >> 9) & 3, b = gid >> 11;
    bf16_t* oout = F.og() + (size_t)dir * MR * 1024;
    const float* wg = F.in[I_GLAWG] + ((size_t)l * 2 + dir) * 16 * 512 + h * 128; const float* bg = F.in[I_GLABG] + ((size_t)l * 2 + dir) * 512 + h * 128;
    float* S = (float*)(F.ws + WS_IDX) + gid;
    for (int k = 0; k < 128; ++k) S[k * 8192] = 0.f;
    for (int seg = 0; seg < 2; ++seg) { const int nn = seg ? SEQ : LCTX, base = seg ? b * SEQ : RX + b * LCTX;
        for (int i = 0; i < nn; ++i) { const int ps = dir ? (nn - 1 - i) : i; const size_t row = (size_t)(base + ps); const bf16_t* rp = F.p1() + row * P1W;
            float gl[16];
#pragma unroll
            for (int r = 0; r < 16; ++r) gl[r] = F.glr()[row * 32 + dir * 16 + r];
            const float vv = bf2f(rp[C_GV + h * 256 + v]); float o = 0.f;
#pragma unroll 1
            for (int k = 0; k < 128; ++k) { float lg = bg[k];
#pragma unroll
                for (int r = 0; r < 16; ++r) lg += gl[r] * wg[r * 512 + k];
                const float ls = fminf(lg, 0.f) - log1pf(expf(-fabsf(lg))); const float eg = expf(ls * (1.f / 16.f));
                const float sn = eg * S[k * 8192] + bf2f(rp[C_GK + h * 128 + k]) * vv; S[k * 8192] = sn; o += bf2f(rp[C_GQ + h * 128 + k]) * 0.08838834764831845f * sn; }
            oout[row * 1024 + h * 256 + v] = f2bf(o); } }
}
#endif
template <int MODE>
__device__ __forceinline__ void attn_task(Frame& F, int l, int b, int h, int qi, const float* srpb, float shift2, float sink2, bool has_sink, bf16_t* outb, int lane) {
    const int c = lane & 15, g = lane >> 4;
    constexpr bool NA = (MODE == 0 || MODE == 2);
    const int hk = NA ? h : (h >> 2);
    const int qcoff = NA ? (C_NA + h * 64) : (C_SQ + h * 64), kcoff = NA ? (C_NA + 1024 + h * 64) : (C_SK + hk * 64);
    const bf16_t* vt = NA ? F.vtna() + (size_t)(b * 16 + h) * 64 * VTS : F.vtsw() + (size_t)(b * 4 + hk) * 64 * VTS;
    int qrow0, r = 0, qt = 0, r0 = 0, ct0 = 0, tq = 0;
    if (MODE == 0) { r = qi >> 2; qt = qi & 3; qrow0 = b * SEQ + r * 64 + qt * 16; r0 = min(max(r - 4, 0), 56); ct0 = (qt >= 2) ? 1 : 0; }
    else if (MODE == 1) { tq = qi; qrow0 = b * SEQ + tq * 16; }
    else qrow0 = RX + b * LCTX + qi * 16;
    constexpr int NG = (MODE == 0) ? 20 : (MODE == 1) ? 17 : 8;
    const bf16_t* p1 = F.p1();
    bf16x8 qf[2];
#pragma unroll
    for (int s = 0; s < 2; ++s) qf[s] = *(const bf16x8*)(p1 + (size_t)(qrow0 + c) * P1W + qcoff + 32 * s + 8 * g);
    f32x4 O[4];
#pragma unroll
    for (int dt = 0; dt < 4; ++dt) O[dt] = (f32x4){0.f, 0.f, 0.f, 0.f};
    float lsum = 0.f;
    const int qc = qt * 16 + c, cs = min(max(qc - 8, 0), 48);
    const int qtok = tq * 16 + c;
    auto tile_of = [&](int ti, int& krow, int& vtile, bool& tok_ok, int& kr, int& kc0) {
        tok_ok = true; kr = 0; kc0 = 0;
        if (MODE == 0) { if (ti < 24) { const int kr_ = r0 + ti / 3, ct = ct0 + ti % 3; kr = kr_; kc0 = ct * 16; krow = b * SEQ + kr_ * 64 + ct * 16; vtile = kr_ * 4 + ct; }
                         else { krow = RX + b * LCTX + (ti - 24) * 16; vtile = 256 + (ti - 24); kr = -1; } }
        else if (MODE == 1) { if (ti < 17) { int tk = tq - 8 + ti; tok_ok = (tk >= 0 && tk < 256); tk = min(max(tk, 0), 255); kc0 = tk * 16; krow = b * SEQ + tk * 16; vtile = tk; }
                              else if (ti < 33) { krow = RX + b * LCTX + (ti - 17) * 16; vtile = 256 + (ti - 17); kr = -1; }
                              else { krow = RX + b * LCTX; vtile = 256; tok_ok = false; kr = -2; } }
        else { krow = RX + b * LCTX + ti * 16; vtile = 256 + ti; kr = -1; }
    };
    bf16x8 kf[2][2], kn[2][2]; u32x2 vf[4][2], vn[4][2];
    auto load_group = [&](int gi, bf16x8 (&K)[2][2], u32x2 (&V)[4][2]) {
#pragma unroll
        for (int tt = 0; tt < 2; ++tt) { int krow, vtile, kr, kc0; bool ok; tile_of(gi * 2 + tt, krow, vtile, ok, kr, kc0);
            const bf16_t* kp = p1 + (size_t)(krow + c) * P1W + kcoff + 8 * g; K[tt][0] = *(const bf16x8*)kp; K[tt][1] = *(const bf16x8*)(kp + 32);
#pragma unroll
            for (int dt = 0; dt < 4; ++dt) V[dt][tt] = *(const u32x2*)(vt + (((size_t)vtile * 4 + dt) * 16 + c) * 16 + 4 * g); }
    };
    load_group(0, kf, vf);
#pragma unroll 1
    for (int gi = 0; gi < NG; ++gi) {
        if (gi + 1 < NG) load_group(gi + 1, kn, vn);
        f32x4 S[2]; bool tok_ok[2]; int kr_[2], kc0_[2];
#pragma unroll
        for (int tt = 0; tt < 2; ++tt) { int krow, vtile; tile_of(gi * 2 + tt, krow, vtile, tok_ok[tt], kr_[tt], kc0_[tt]);
            S[tt] = __builtin_amdgcn_mfma_f32_16x16x32_bf16(kf[tt][0], qf[0], (f32x4){0.f, 0.f, 0.f, 0.f}, 0, 0, 0);
            S[tt] = __builtin_amdgcn_mfma_f32_16x16x32_bf16(kf[tt][1], qf[1], S[tt], 0, 0, 0); }
        float p[2][4];
#pragma unroll
        for (int tt = 0; tt < 2; ++tt)
#pragma unroll
            for (int rr = 0; rr < 4; ++rr) {
                float lg = S[tt][rr]; bool ok = tok_ok[tt];
                if (MODE == 0) { if (kr_[tt] >= 0) { const int kc = kc0_[tt] + 4 * g + rr; ok = (kc >= cs) && (kc < cs + 16); const int bi = (kr_[tt] - r + 7) * 31 + (kc - qc + 15); lg += ok ? srpb[bi] : 0.f; } }
                if (MODE == 1) { if (kr_[tt] == 0) { const int kt = kc0_[tt] + 4 * g + rr; const int dd = qtok - kt; ok = ok && (dd <= 128) && (dd >= -128); } }
                const float e = __builtin_amdgcn_exp2f(lg * 1.4426950408889634f - shift2);
                p[tt][rr] = ok ? e : 0.f; lsum += p[tt][rr];
            }
        u32x4 pw; pw.x = pg8::cvt_pk_bf16(p[0][0], p[0][1]); pw.y = pg8::cvt_pk_bf16(p[0][2], p[0][3]); pw.z = pg8::cvt_pk_bf16(p[1][0], p[1][1]); pw.w = pg8::cvt_pk_bf16(p[1][2], p[1][3]);
        const bf16x8 pb = __builtin_bit_cast(bf16x8, pw);
#pragma unroll
        for (int dt = 0; dt < 4; ++dt) { u32x4 vw; vw.x = vf[dt][0].x; vw.y = vf[dt][0].y; vw.z = vf[dt][1].x; vw.w = vf[dt][1].y;
            O[dt] = __builtin_amdgcn_mfma_f32_16x16x32_bf16(__builtin_bit_cast(bf16x8, vw), pb, O[dt], 0, 0, 0); }
#pragma unroll
        for (int tt = 0; tt < 2; ++tt) { kf[tt][0] = kn[tt][0]; kf[tt][1] = kn[tt][1];
#pragma unroll
            for (int dt = 0; dt < 4; ++dt) vf[dt][tt] = vn[dt][tt]; }
    }
    lsum += xsw<16>(lsum); lsum += xsw<32>(lsum);
    if (has_sink) lsum += __builtin_amdgcn_exp2f(sink2 - shift2);
    const float inv = 1.f / lsum;
    bf16_t* op = outb + (size_t)(qrow0 + c) * 4096 + h * 64 + 4 * g;
#pragma unroll
    for (int dt = 0; dt < 4; ++dt) { u32x2 w; w.x = pg8::cvt_pk_bf16(O[dt][0] * inv, O[dt][1] * inv); w.y = pg8::cvt_pk_bf16(O[dt][2] * inv, O[dt][3] * inv); *(u32x2*)(op + dt * 16) = w; }
}

#ifndef ATT_K2
#define ATT_K2 0
#endif
template <int MODE>
__device__ __forceinline__ void attn_task4(Frame& F, int l, int b, int hx_, int qi, const float* srpb, float shift2, const float* sinkp, bf16_t* outb, int lane) {
    const int c = lane & 15, g = lane >> 4;
    constexpr bool NA = (MODE == 0 || MODE == 2);
    const int h0 = NA ? hx_ : hx_ * 4;
    const int kcoff = NA ? (C_NA + 1024 + hx_ * 64) : (C_SK + hx_ * 64);
    const bf16_t* vt = NA ? F.vtna() + (size_t)(b * 16 + hx_) * 64 * VTS : F.vtsw() + (size_t)(b * 4 + hx_) * 64 * VTS;
    const int r = qi, r0 = min(max(r - 4, 0), 56), tq = qi;
    const bf16_t* p1 = F.p1();
    int qrow[4], qcol[4];
#pragma unroll
    for (int j = 0; j < 4; ++j) {
        if (MODE == 0) { qrow[j] = b * SEQ + r * 64 + j * 16; qcol[j] = C_NA + hx_ * 64; }
        else if (MODE == 2) { qrow[j] = RX + b * LCTX + (qi * 4 + j) * 16; qcol[j] = C_NA + hx_ * 64; }
        else if (MODE == 1) { qrow[j] = b * SEQ + tq * 16; qcol[j] = C_SQ + (h0 + j) * 64; }
        else { qrow[j] = RX + b * LCTX + qi * 16; qcol[j] = C_SQ + (h0 + j) * 64; } }
    bf16x8 qf[4][2];
#pragma unroll
    for (int j = 0; j < 4; ++j)
#pragma unroll
        for (int s = 0; s < 2; ++s) qf[j][s] = *(const bf16x8*)(p1 + (size_t)(qrow[j] + c) * P1W + qcol[j] + 32 * s + 8 * g);
    f32x4 O[4][4]; float lsum[4];
#pragma unroll
    for (int j = 0; j < 4; ++j) { lsum[j] = 0.f;
#pragma unroll
        for (int dt = 0; dt < 4; ++dt) O[j][dt] = (f32x4){0.f, 0.f, 0.f, 0.f}; }
    constexpr int NG = (MODE == 0) ? 24 : (MODE == 1) ? 17 : 8;
    const int qtok = tq * 16 + c;
    auto tile_of = [&](int gi, int tt, int& krow, int& vtile, bool& tok_ok, int& kr, int& kc0) {
        tok_ok = true; kr = -1; kc0 = 0;
        if (MODE == 0) { if (gi < 16) { const int kr_ = r0 + (gi >> 1), ct = (gi & 1) * 2 + tt; kr = kr_; kc0 = ct * 16; krow = b * SEQ + kr_ * 64 + ct * 16; vtile = kr_ * 4 + ct; }
                         else { const int ci = (gi - 16) * 2 + tt; krow = RX + b * LCTX + ci * 16; vtile = 256 + ci; } }
        else if (MODE == 1) { const int ti = gi * 2 + tt;
                              if (ti < 17) { int tk = tq - 8 + ti; tok_ok = (tk >= 0 && tk < 256); tk = min(max(tk, 0), 255); kr = 0; kc0 = tk * 16; krow = b * SEQ + tk * 16; vtile = tk; }
                              else if (ti < 33) { krow = RX + b * LCTX + (ti - 17) * 16; vtile = 256 + (ti - 17); }
                              else { krow = RX + b * LCTX; vtile = 256; tok_ok = false; kr = -2; } }
        else { const int ti = gi * 2 + tt; krow = RX + b * LCTX + ti * 16; vtile = 256 + ti; }
    };
    bf16x8 kf[2][2], kn[2][2], k2[2][2]; u32x2 vf[4][2], vn[4][2];
    auto load_k = [&](int gi, bf16x8 (&K)[2][2]) {
#pragma unroll
        for (int tt = 0; tt < 2; ++tt) { int krow, vtile, kr, kc0; bool ok; tile_of(gi, tt, krow, vtile, ok, kr, kc0);
            const bf16_t* kp = p1 + (size_t)(krow + c) * P1W + kcoff + 8 * g; K[tt][0] = *(const bf16x8*)kp; K[tt][1] = *(const bf16x8*)(kp + 32); }
    };
    auto load_v = [&](int gi, u32x2 (&V)[4][2]) {
#pragma unroll
        for (int tt = 0; tt < 2; ++tt) { int krow, vtile, kr, kc0; bool ok; tile_of(gi, tt, krow, vtile, ok, kr, kc0);
#pragma unroll
            for (int dt = 0; dt < 4; ++dt) V[dt][tt] = *(const u32x2*)(vt + (((size_t)vtile * 4 + dt) * 16 + c) * 16 + 4 * g); }
    };
    load_k(0, kf); load_v(0, vf);
#if ATT_K2
    load_k(1, kn);
#endif
#pragma unroll
    for (int j = 0; j < 4; ++j) asm volatile("" : "+v"(qf[j][0]), "+v"(qf[j][1]));
#pragma unroll
    for (int tt = 0; tt < 2; ++tt) { asm volatile("" : "+v"(kf[tt][0]), "+v"(kf[tt][1]));
#pragma unroll
        for (int dt = 0; dt < 4; ++dt) asm volatile("" : "+v"(vf[dt][tt])); }
#pragma unroll 1
    for (int gi = 0; gi < NG; ++gi) {
        if (gi + 1 < NG) load_v(gi + 1, vn);
#if ATT_K2
        if (gi + 2 < NG) load_k(gi + 2, k2);
#else
        if (gi + 1 < NG) load_k(gi + 1, kn);
#endif
        int gq = g, cq = c; asm volatile("" : "+v"(gq), "+v"(cq));
        bool tok_ok[2]; int kr_[2], kc0_[2];
#pragma unroll
        for (int tt = 0; tt < 2; ++tt) { int krow, vtile; tile_of(gi, tt, krow, vtile, tok_ok[tt], kr_[tt], kc0_[tt]); }
#pragma unroll
        for (int j = 0; j < 4; ++j) {
            bool rel = true;
            if (MODE == 0) { if (gi < 16) rel = ((gi & 1) == 0) ? (j <= 2) : (j >= 1); }
            if (rel) {
                f32x4 S[2];
#pragma unroll
                for (int tt = 0; tt < 2; ++tt) { S[tt] = __builtin_amdgcn_mfma_f32_16x16x32_bf16(kf[tt][0], qf[j][0], (f32x4){0.f, 0.f, 0.f, 0.f}, 0, 0, 0);
                    S[tt] = __builtin_amdgcn_mfma_f32_16x16x32_bf16(kf[tt][1], qf[j][1], S[tt], 0, 0, 0); }
                float p[2][4];
                const int qc = j * 16 + cq, cs = min(max(qc - 8, 0), 48);
#pragma unroll
                for (int tt = 0; tt < 2; ++tt)
#pragma unroll
                    for (int rr = 0; rr < 4; ++rr) {
                        float lg = S[tt][rr]; bool ok = tok_ok[tt];
                        if (MODE == 0) { const bool latk = kr_[tt] >= 0; const int kc = kc0_[tt] + 4 * gq + rr; const bool inw = (unsigned)(kc - cs) < 16u; const int bi = (kr_[tt] - r + 7) * 31 + (kc - qc + 15); const float bv = srpb[bi];
                            lg += (latk && inw) ? bv : 0.f; ok = latk ? inw : true; }
                        if (MODE == 1) { if (kr_[tt] == 0) { const int kt = kc0_[tt] + 4 * gq + rr; const int dd = (tq * 16 + cq) - kt; ok = ok && ((unsigned)(dd + 128) <= 256u); } }
                        const float e = __builtin_amdgcn_exp2f(lg * 1.4426950408889634f - shift2);
                        p[tt][rr] = ok ? e : 0.f; lsum[j] += p[tt][rr];
                    }
                u32x4 pw; pw.x = pg8::cvt_pk_bf16(p[0][0], p[0][1]); pw.y = pg8::cvt_pk_bf16(p[0][2], p[0][3]); pw.z = pg8::cvt_pk_bf16(p[1][0], p[1][1]); pw.w = pg8::cvt_pk_bf16(p[1][2], p[1][3]);
                const bf16x8 pb = __builtin_bit_cast(bf16x8, pw);
#pragma unroll
                for (int dt = 0; dt < 4; ++dt) { u32x4 vw; vw.x = vf[dt][0].x; vw.y = vf[dt][0].y; vw.z = vf[dt][1].x; vw.w = vf[dt][1].y;
                    O[j][dt] = __builtin_amdgcn_mfma_f32_16x16x32_bf16(__builtin_bit_cast(bf16x8, vw), pb, O[j][dt], 0, 0, 0); }
            }
            if (j & 1) __builtin_amdgcn_sched_barrier(0);
        }
#pragma unroll
        for (int tt = 0; tt < 2; ++tt) { kf[tt][0] = kn[tt][0]; kf[tt][1] = kn[tt][1];
#if ATT_K2
            kn[tt][0] = k2[tt][0]; kn[tt][1] = k2[tt][1];
#endif
#pragma unroll
            for (int dt = 0; dt < 4; ++dt) vf[dt][tt] = vn[dt][tt]; }
    }
#pragma unroll
    for (int j = 0; j < 4; ++j) {
        float ls = lsum[j]; ls += xsw<16>(ls); ls += xsw<32>(ls);
        if (MODE == 1 || MODE == 3) ls += __builtin_amdgcn_exp2f(sinkp[h0 + j] * 1.4426950408889634f - shift2);
        const float inv = 1.f / ls; const int hh = NA ? hx_ : (h0 + j);
        bf16_t* op = outb + (size_t)(qrow[j] + c) * 4096 + hh * 64 + 4 * g;
#pragma unroll
        for (int dt = 0; dt < 4; ++dt) { u32x2 w; w.x = pg8::cvt_pk_bf16(O[j][dt][0] * inv, O[j][dt][1] * inv); w.y = pg8::cvt_pk_bf16(O[j][dt][2] * inv, O[j][dt][3] * inv); *(u32x2*)(op + dt * 16) = w; }
    }
}
typedef short s16x4 __attribute__((ext_vector_type(4)));
__device__ __forceinline__ void lds_barrier() { asm volatile("s_waitcnt lgkmcnt(0)" ::: "memory"); __builtin_amdgcn_s_barrier(); asm volatile("" ::: "memory"); }
constexpr int CH_QM = 0, CH_KM = 17408, CH_QS = 34816, CH_KS = 52224, CH_V = 69632, CH_AM = 78848, CH_S = 88064, CH_GC = 105472, CH_GL = 138240, CH_TOT = 142336, CH_CST = 144384, CH_CS = 145920;
constexpr int ST128 = 272, ST64 = 144;
__device__ __forceinline__ bf16x8 row_frag(LAS const unsigned char* t, int stride, int row, int kbyte) { return *(LAS const bf16x8*)(t + row * stride + kbyte); }
__device__ __forceinline__ bf16x8 tr_frag(LAS const unsigned char* t, int stride, int k0, int c0, int lane) {
    const int g = lane >> 4, i = lane & 15, q = i >> 2, p = i & 3;
    LAS const unsigned char* a = t + (k0 + 8 * g + q) * stride + (c0 + 4 * p) * 2;
    const s16x4 lo = __builtin_amdgcn_ds_read_tr16_b64_v4i16((LAS s16x4*)a), hi = __builtin_amdgcn_ds_read_tr16_b64_v4i16((LAS s16x4*)(a + 4 * stride));
    bf16x8 r; r[0] = lo[0]; r[1] = lo[1]; r[2] = lo[2]; r[3] = lo[3]; r[4] = hi[0]; r[5] = hi[1]; r[6] = hi[2]; r[7] = hi[3]; return r;
}
constexpr int CH_V2 = 122880, CH_S2 = 105472;
template <int KIND>
__device__ __forceinline__ void chain_mfma(Frame& F, int l, int b, int h, int dir, int vs) {
    constexpr int NV = (KIND == 1) ? 2 : 1;
    LAS unsigned char* L = F.lds;
    const int tid = F.tid, lane = F.lane, wave = F.wave, g = lane >> 4, i16 = lane & 15;
    const int cc = tid & 15, rg = tid >> 4;
    const int vrow = tid >> 3, vch = tid & 7;
    const bf16_t* xact = F.hn(); const bf16_t* p1 = F.p1();
    bf16_t* outp = (KIND == 0 ? F.ys() : F.og()) + (size_t)dir * MR * 1024;
    const int ocol = KIND == 0 ? h * 64 : h * 256 + vs * 128;
    float a_ssd = 0.f;
    if (KIND == 0) a_ssd = -expf(F.in[I_ALOG][l * 32 + dir * 16 + h]);

    f32x4 Sacc[NV][4];
#pragma unroll
    for (int sv = 0; sv < NV; ++sv)
#pragma unroll
        for (int v = 0; v < 4; ++v) Sacc[sv][v] = (f32x4){0.f, 0.f, 0.f, 0.f};
    __syncthreads();
    for (int e = tid; e < 17408 / 4; e += 512) { ((LAS unsigned*)(L + CH_S))[e] = 0u; if (NV == 2) ((LAS unsigned*)(L + CH_S2))[e] = 0u; }
    auto rowof = [&](int t) -> int { const bool lat = t >= LCTX; const int n = lat ? SEQ : LCTX, tt = lat ? t - LCTX : t, base = lat ? b * SEQ : RX + b * LCTX; return base + (dir ? (n - 1 - tt) : tt); };
    u32x4 rq[2], rk[2], rv, rv2 = (u32x4){0u, 0u, 0u, 0u}; float rg0 = 0.f, rcs0 = 0.f, rcs1 = 0.f, rcs63 = 0.f, rcsl = 0.f; f32x4 gq[2][2], gref[2], gend[2];
    auto prefetch = [&](int t0) {
#pragma unroll
        for (int j = 0; j < 2; ++j) { const size_t row = (size_t)rowof(t0 + rg + 32 * j);
            if (KIND == 0) { rq[j] = *(const u32x4*)(xact + row * 2048 + 1536 + (h >> 2) * 128 + cc * 8); rk[j] = *(const u32x4*)(xact + row * 2048 + 1024 + (h >> 2) * 128 + cc * 8); }
            else { rq[j] = *(const u32x4*)(p1 + row * P1W + C_GQ + h * 128 + cc * 8); rk[j] = *(const u32x4*)(p1 + row * P1W + C_GK + h * 128 + cc * 8);
                   const float* gp = F.gcum() + ((size_t)dir * MR + row) * 512 + h * 128 + cc * 8; gq[j][0] = *(const f32x4*)gp; gq[j][1] = *(const f32x4*)(gp + 4); } }
        if (KIND == 1) { const float* gr = F.gcum() + ((size_t)dir * MR + rowof(t0 + 31)) * 512 + h * 128 + cc * 8; const float* ge = F.gcum() + ((size_t)dir * MR + rowof(t0 + 63)) * 512 + h * 128 + cc * 8;
            gref[0] = *(const f32x4*)gr; gref[1] = *(const f32x4*)(gr + 4); gend[0] = *(const f32x4*)ge; gend[1] = *(const f32x4*)(ge + 4); }
        { const size_t row = (size_t)rowof(t0 + vrow);
            if (KIND == 0) { rv = *(const u32x4*)(xact + row * 2048 + h * 64 + vch * 8); rg0 = F.dt()[row * 32 + dir * 16 + h];
                const float* cp = F.csum() + (size_t)dir * MR * 16 + h;
                rcs0 = cp[(size_t)rowof(t0 + rg) * 16]; rcs1 = cp[(size_t)rowof(t0 + rg + 32) * 16]; rcs63 = cp[(size_t)rowof(t0 + 63) * 16]; rcsl = (tid < 64) ? cp[(size_t)rowof(t0 + tid) * 16] : 0.f; }
            else { rv = *(const u32x4*)(p1 + row * P1W + C_GV + h * 256 + vs * 128 + vch * 8); rv2 = *(const u32x4*)(p1 + row * P1W + C_GV + h * 256 + vs * 128 + 64 + vch * 8); } }
    };
    prefetch(0);
    LAS float* gcT = (LAS float*)(L + CH_GC); LAS float* glT = (LAS float*)(L + CH_GL); LAS float* totT = (LAS float*)(L + CH_TOT); LAS float* cstT = (LAS float*)(L + CH_CST); LAS float* csT = (LAS float*)(L + CH_CS);
#pragma unroll 1
    for (int t0 = 0; t0 < LCTX + SEQ; t0 += 64) {
        if (KIND == 0) { if (tid < 64) csT[tid] = rcsl; }
        float egr[8], eger[8];
        if (KIND == 1) {
#pragma unroll
            for (int e = 0; e < 8; ++e) { const float gr = gref[e >> 2][e & 3]; egr[e] = __expf(gr); eger[e] = __expf(gend[e >> 2][e & 3] - gr); } }
#pragma unroll
        for (int j = 0; j < 2; ++j) { const int lr = rg + 32 * j;
            float q8[8] = {lo2f(rq[j].x), hi2f(rq[j].x), lo2f(rq[j].y), hi2f(rq[j].y), lo2f(rq[j].z), hi2f(rq[j].z), lo2f(rq[j].w), hi2f(rq[j].w)};
            float k8[8] = {lo2f(rk[j].x), hi2f(rk[j].x), lo2f(rk[j].y), hi2f(rk[j].y), lo2f(rk[j].z), hi2f(rk[j].z), lo2f(rk[j].w), hi2f(rk[j].w)};
            float qm[8], km[8], qs[8], ks[8];
            if (KIND == 0) { const float csl = j ? rcs1 : rcs0; const float e1 = __expf(csl), e2 = __expf(rcs63 - csl);
#pragma unroll
                for (int e = 0; e < 8; ++e) { qm[e] = q8[e]; km[e] = k8[e]; qs[e] = q8[e] * e1; ks[e] = k8[e] * e2; } }
            else {
#pragma unroll
                for (int e = 0; e < 8; ++e) { const float gl = gq[j][e >> 2][e & 3], gr = gref[e >> 2][e & 3];
                    const float e1 = __expf(gl - gr), e2 = __builtin_amdgcn_rcpf(e1);
                    const float qq = q8[e] * 0.08838834764831845f; qm[e] = qq * e1; km[e] = k8[e] * e2; qs[e] = qm[e] * egr[e]; ks[e] = km[e] * eger[e]; } }
            u32x4 w;
            w.x = pack2(qm[0], qm[1]); w.y = pack2(qm[2], qm[3]); w.z = pack2(qm[4], qm[5]); w.w = pack2(qm[6], qm[7]); *(LAS u32x4*)(L + CH_QM + lr * ST128 + cc * 16) = w;
            w.x = pack2(km[0], km[1]); w.y = pack2(km[2], km[3]); w.z = pack2(km[4], km[5]); w.w = pack2(km[6], km[7]); *(LAS u32x4*)(L + CH_KM + lr * ST128 + cc * 16) = w;
            w.x = pack2(qs[0], qs[1]); w.y = pack2(qs[2], qs[3]); w.z = pack2(qs[4], qs[5]); w.w = pack2(qs[6], qs[7]); *(LAS u32x4*)(L + CH_QS + lr * ST128 + cc * 16) = w;
            w.x = pack2(ks[0], ks[1]); w.y = pack2(ks[2], ks[3]); w.z = pack2(ks[4], ks[5]); w.w = pack2(ks[6], ks[7]); *(LAS u32x4*)(L + CH_KS + lr * ST128 + cc * 16) = w; }
        if (KIND == 1) { if (rg == 0) {
#pragma unroll
                for (int e = 0; e < 8; ++e) cstT[256 + cc * 8 + e] = __expf(gend[e >> 2][e & 3]); } }
        { u32x4 w = rv;
            if (KIND == 0) { const float d = rg0;
                w.x = pack2(lo2f(rv.x) * d, hi2f(rv.x) * d); w.y = pack2(lo2f(rv.y) * d, hi2f(rv.y) * d); w.z = pack2(lo2f(rv.z) * d, hi2f(rv.z) * d); w.w = pack2(lo2f(rv.w) * d, hi2f(rv.w) * d); }
            *(LAS u32x4*)(L + CH_V + vrow * ST64 + vch * 16) = w; if (NV == 2) *(LAS u32x4*)(L + CH_V2 + vrow * ST64 + vch * 16) = rv2; }
        const float ds_ssd = (KIND == 0) ? __expf(rcs63) : 0.f;
        lds_barrier();
        float dS[4];
#pragma unroll
        for (int r = 0; r < 4; ++r) dS[r] = (KIND == 0) ? ds_ssd : cstT[256 + wave * 16 + 4 * g + r];
        if (t0 + 64 < LCTX + SEQ) prefetch(t0 + 64);
        for (int tix = wave; tix < 12; tix += 8) {
            int li, sj; if (tix == 0) { li = 0; sj = 0; } else if (tix < 3) { li = 1; sj = tix - 1; } else if (tix < 6) { li = 2; sj = tix - 3; } else if (tix < 10) { li = 3; sj = tix - 6; } else { li = (tix - 10) * 2; sj = li + 1; }
            f32x4 acc = (f32x4){0.f, 0.f, 0.f, 0.f};
            if (tix < 10) {
#pragma unroll
                for (int ks_ = 0; ks_ < 4; ++ks_) acc = __builtin_amdgcn_mfma_f32_16x16x32_bf16(row_frag(L + CH_KM, ST128, sj * 16 + i16, ks_ * 64 + g * 16), row_frag(L + CH_QM, ST128, li * 16 + i16, ks_ * 64 + g * 16), acc, 0, 0, 0);
                const int lrow = li * 16 + i16;
#pragma unroll
                for (int r = 0; r < 4; ++r) { const int s = sj * 16 + 4 * g + r; float v = acc[r];
                    if (KIND == 0) v *= __expf(fminf(csT[lrow] - csT[s], 0.f));
                    acc[r] = (s <= lrow) ? v : 0.f; } }
            u32x2 w; w.x = pack2(acc[0], acc[1]); w.y = pack2(acc[2], acc[3]);
            *(LAS u32x2*)(L + CH_AM + (li * 16 + i16) * ST64 + (sj * 16 + 4 * g) * 2) = w;
        }
        lds_barrier();
#pragma unroll
        for (int sv = 0; sv < NV; ++sv) { LAS unsigned char* Ss = L + (sv ? CH_S2 : CH_S); LAS unsigned char* Vs = L + (sv ? CH_V2 : CH_V);
#pragma unroll
        for (int tt = 0; tt < 2; ++tt) { const int tile = wave * 2 + tt, vi = tile >> 2, li = tile & 3;
            f32x4 acc = (f32x4){0.f, 0.f, 0.f, 0.f};
#pragma unroll
            for (int ks_ = 0; ks_ < 4; ++ks_) acc = __builtin_amdgcn_mfma_f32_16x16x32_bf16(row_frag(Ss, ST128, vi * 16 + i16, ks_ * 64 + g * 16), row_frag(L + CH_QS, ST128, li * 16 + i16, ks_ * 64 + g * 16), acc, 0, 0, 0);
            for (int kk = 0; kk <= (li >> 1); ++kk) acc = __builtin_amdgcn_mfma_f32_16x16x32_bf16(tr_frag(Vs, ST64, kk * 32, vi * 16, lane), row_frag(L + CH_AM, ST64, li * 16 + i16, kk * 64 + g * 16), acc, 0, 0, 0);
            const int lrow = li * 16 + i16; u32x2 w; w.x = pack2(acc[0], acc[1]); w.y = pack2(acc[2], acc[3]);
            *(u32x2*)(outp + (size_t)rowof(t0 + lrow) * 1024 + ocol + sv * 64 + vi * 16 + 4 * g) = w; } }
        { bf16x8 ka[2];
#pragma unroll
            for (int kk = 0; kk < 2; ++kk) ka[kk] = tr_frag(L + CH_KS, ST128, kk * 32, wave * 16, lane);
#pragma unroll
            for (int sv = 0; sv < NV; ++sv)
#pragma unroll
            for (int vi = 0; vi < 4; ++vi) {
#pragma unroll
                for (int r = 0; r < 4; ++r) Sacc[sv][vi][r] *= dS[r];
#pragma unroll
                for (int kk = 0; kk < 2; ++kk) Sacc[sv][vi] = __builtin_amdgcn_mfma_f32_16x16x32_bf16(ka[kk], tr_frag(L + (sv ? CH_V2 : CH_V), ST64, kk * 32, vi * 16, lane), Sacc[sv][vi], 0, 0, 0); } }
        lds_barrier();
#pragma unroll
        for (int sv = 0; sv < NV; ++sv)
#pragma unroll
        for (int vi = 0; vi < 4; ++vi) { u32x2 w; w.x = pack2(Sacc[sv][vi][0], Sacc[sv][vi][1]); w.y = pack2(Sacc[sv][vi][2], Sacc[sv][vi][3]);
            *(LAS u32x2*)(L + (sv ? CH_S2 : CH_S) + (vi * 16 + i16) * ST128 + (wave * 16 + 4 * g) * 2) = w; }
    }
    __syncthreads();
}

constexpr int C2_QM = 0, C2_KM = 17408, C2_S1 = 34816, C2_V1 = 52224, C2_W1 = 123904, C2_V0 = 69632, C2_AM0 = 78848, C2_S0 = 88064, C2_W0 = 105472, C2_AM1 = 114688, C2_CS = 145920;
__device__ __forceinline__ void chain_ssd2(Frame& F, int l, int b, int hp, int dir) {
    LAS unsigned char* L = F.lds;
    const int tid = F.tid, lane = F.lane, wave = F.wave, g = lane >> 4, i16 = lane & 15;
    const int cc = tid & 15, rg = tid >> 4, vrow = tid >> 3, vch = tid & 7;
    const bf16_t* xact = F.hn();
    bf16_t* outp = F.ys() + (size_t)dir * MR * 1024;
    const int h0 = hp * 2, grp = h0 >> 2;
    f32x4 Sacc[2][4];
#pragma unroll
    for (int hd = 0; hd < 2; ++hd)
#pragma unroll
        for (int v = 0; v < 4; ++v) Sacc[hd][v] = (f32x4){0.f, 0.f, 0.f, 0.f};
    __syncthreads();
    for (int e = tid; e < 17408 / 4; e += 512) { ((LAS unsigned*)(L + C2_S0))[e] = 0u; ((LAS unsigned*)(L + C2_S1))[e] = 0u; }
    auto rowof = [&](int t) -> int { const bool lat = t >= LCTX; const int n = lat ? SEQ : LCTX, tt = lat ? t - LCTX : t, base = lat ? b * SEQ : RX + b * LCTX; return base + (dir ? (n - 1 - tt) : tt); };
    u32x4 rq[2], rk[2], rv[2]; float rdt[2], rcsv[2], rcs63[2], rcsl[2];
    auto prefetch = [&](int t0) {
#pragma unroll
        for (int j = 0; j < 2; ++j) { const size_t row = (size_t)rowof(t0 + rg + 32 * j);
            rq[j] = *(const u32x4*)(xact + row * 2048 + 1536 + grp * 128 + cc * 8); rk[j] = *(const u32x4*)(xact + row * 2048 + 1024 + grp * 128 + cc * 8); }
        const size_t vr = (size_t)rowof(t0 + vrow), r63 = (size_t)rowof(t0 + 63), rl = (size_t)rowof(t0 + (tid & 63));
#pragma unroll
        for (int hd = 0; hd < 2; ++hd) { const int h = h0 + hd; const float* cp = F.csum() + (size_t)dir * MR * 16 + h;
            rv[hd] = *(const u32x4*)(xact + vr * 2048 + h * 64 + vch * 8); rdt[hd] = F.dt()[vr * 32 + dir * 16 + h];
            rcsv[hd] = cp[vr * 16]; rcs63[hd] = cp[r63 * 16]; rcsl[hd] = cp[rl * 16]; }
    };
    prefetch(0);
    LAS float* csT = (LAS float*)(L + C2_CS);
#pragma unroll 1
    for (int t0 = 0; t0 < LCTX + SEQ; t0 += 64) {
        if (tid < 128) csT[tid] = (tid < 64) ? rcsl[0] : rcsl[1];
#pragma unroll
        for (int j = 0; j < 2; ++j) { const int lr = rg + 32 * j; *(LAS u32x4*)(L + C2_QM + lr * ST128 + cc * 16) = rq[j]; *(LAS u32x4*)(L + C2_KM + lr * ST128 + cc * 16) = rk[j]; }
        float dSh[2];
#pragma unroll
        for (int hd = 0; hd < 2; ++hd) { const float d = rdt[hd], e2 = __expf(rcs63[hd] - rcsv[hd]); const u32x4 x = rv[hd]; u32x4 w, w2;
            const float f0 = lo2f(x.x) * d, f1 = hi2f(x.x) * d, f2 = lo2f(x.y) * d, f3 = hi2f(x.y) * d, f4 = lo2f(x.z) * d, f5 = hi2f(x.z) * d, f6 = lo2f(x.w) * d, f7 = hi2f(x.w) * d;
            w.x = pack2(f0, f1); w.y = pack2(f2, f3); w.z = pack2(f4, f5); w.w = pack2(f6, f7);
            w2.x = pack2(f0 * e2, f1 * e2); w2.y = pack2(f2 * e2, f3 * e2); w2.z = pack2(f4 * e2, f5 * e2); w2.w = pack2(f6 * e2, f7 * e2);
            *(LAS u32x4*)(L + (hd ? C2_V1 : C2_V0) + vrow * ST64 + vch * 16) = w; *(LAS u32x4*)(L + (hd ? C2_W1 : C2_W0) + vrow * ST64 + vch * 16) = w2;
            dSh[hd] = __expf(rcs63[hd]); }
        lds_barrier();
        if (t0 + 64 < LCTX + SEQ) prefetch(t0 + 64);
        for (int tix = wave; tix < 12; tix += 8) {
            int li, sj; if (tix == 0) { li = 0; sj = 0; } else if (tix < 3) { li = 1; sj = tix - 1; } else if (tix < 6) { li = 2; sj = tix - 3; } else if (tix < 10) { li = 3; sj = tix - 6; } else { li = (tix - 10) * 2; sj = li + 1; }
            f32x4 acc = (f32x4){0.f, 0.f, 0.f, 0.f};
            if (tix < 10) {
#pragma unroll
                for (int ks_ = 0; ks_ < 4; ++ks_) acc = __builtin_amdgcn_mfma_f32_16x16x32_bf16(row_frag(L + C2_KM, ST128, sj * 16 + i16, ks_ * 64 + g * 16), row_frag(L + C2_QM, ST128, li * 16 + i16, ks_ * 64 + g * 16), acc, 0, 0, 0); }
            const int lrow = li * 16 + i16;
#pragma unroll
            for (int hd = 0; hd < 2; ++hd) { f32x4 a2 = (f32x4){0.f, 0.f, 0.f, 0.f};
                if (tix < 10) {
#pragma unroll
                    for (int r = 0; r < 4; ++r) { const int s = sj * 16 + 4 * g + r; const float v = acc[r] * __expf(fminf(csT[hd * 64 + lrow] - csT[hd * 64 + s], 0.f)); a2[r] = (s <= lrow) ? v : 0.f; } }
                u32x2 w; w.x = pack2(a2[0], a2[1]); w.y = pack2(a2[2], a2[3]);
                *(LAS u32x2*)(L + (hd ? C2_AM1 : C2_AM0) + lrow * ST64 + (sj * 16 + 4 * g) * 2) = w; }
        }
        lds_barrier();
#pragma unroll
        for (int hd = 0; hd < 2; ++hd) { LAS unsigned char* Ss = L + (hd ? C2_S1 : C2_S0); LAS unsigned char* Vs = L + (hd ? C2_V1 : C2_V0); LAS unsigned char* As = L + (hd ? C2_AM1 : C2_AM0);
#pragma unroll
            for (int tt = 0; tt < 2; ++tt) { const int tile = wave * 2 + tt, vi = tile >> 2, li = tile & 3, lrow = li * 16 + i16;
                f32x4 acc = (f32x4){0.f, 0.f, 0.f, 0.f};
#pragma unroll
                for (int ks_ = 0; ks_ < 4; ++ks_) acc = __builtin_amdgcn_mfma_f32_16x16x32_bf16(row_frag(Ss, ST128, vi * 16 + i16, ks_ * 64 + g * 16), row_frag(L + C2_QM, ST128, lrow, ks_ * 64 + g * 16), acc, 0, 0, 0);
                const float e1 = __expf(csT[hd * 64 + lrow]);
                acc *= e1;
                for (int kk = 0; kk <= (li >> 1); ++kk) acc = __builtin_amdgcn_mfma_f32_16x16x32_bf16(tr_frag(Vs, ST64, kk * 32, vi * 16, lane), row_frag(As, ST64, lrow, kk * 64 + g * 16), acc, 0, 0, 0);
                u32x2 w; w.x = pack2(acc[0], acc[1]); w.y = pack2(acc[2], acc[3]);
                *(u32x2*)(outp + (size_t)rowof(t0 + lrow) * 1024 + (h0 + hd) * 64 + vi * 16 + 4 * g) = w; } }
        { bf16x8 ka[2];
#pragma unroll
            for (int kk = 0; kk < 2; ++kk) ka[kk] = tr_frag(L + C2_KM, ST128, kk * 32, wave * 16, lane);
#pragma unroll
            for (int hd = 0; hd < 2; ++hd)
#pragma unroll
                for (int vi = 0; vi < 4; ++vi) { Sacc[hd][vi] *= dSh[hd];
#pragma unroll
                    for (int kk = 0; kk < 2; ++kk) Sacc[hd][vi] = __builtin_amdgcn_mfma_f32_16x16x32_bf16(ka[kk], tr_frag(L + (hd ? C2_W1 : C2_W0), ST64, kk * 32, vi * 16, lane), Sacc[hd][vi], 0, 0, 0); } }
        lds_barrier();
#pragma unroll
        for (int hd = 0; hd < 2; ++hd)
#pragma unroll
            for (int vi = 0; vi < 4; ++vi) { u32x2 w; w.x = pack2(Sacc[hd][vi][0], Sacc[hd][vi][1]); w.y = pack2(Sacc[hd][vi][2], Sacc[hd][vi][3]);
                *(LAS u32x2*)(L + (hd ? C2_S1 : C2_S0) + (vi * 16 + i16) * ST128 + (wave * 16 + 4 * g) * 2) = w; }
    }
    __syncthreads();
}
__device__ __forceinline__ void ssd_chain(Frame& F, int l, int b, int h, int dir) {
    const bf16_t* xact = F.hn();
    const float a = -expf(F.in[I_ALOG][l * 32 + dir * 16 + h]);
    const int p = F.tid >> 3, nq = F.tid & 7, grp = h >> 2;
    bf16_t* sx = (bf16_t*)F.ldsg;
    bf16_t* sB = (bf16_t*)(F.ldsg + 4096);
    bf16_t* sC = (bf16_t*)(F.ldsg + 4096 + 8192);
    float* sdt = (float*)(F.ldsg + 20480);
    float* sy = (float*)(F.ldsg + 20480 + 128);
    bf16_t* yout = F.ys() + (size_t)dir * MR * 1024;
    float st[16];
#pragma unroll
    for (int i = 0; i < 16; ++i) st[i] = 0.f;
    for (int seg = 0; seg < 2; ++seg) {
        const int n = seg ? SEQ : LCTX, base = seg ? b * SEQ : RX + b * LCTX;
        for (int blk = 0; blk < n; blk += 32) {
            __syncthreads();
            for (int e = F.tid; e < 1280; e += 512) {
                int i, off, ldsoff;
                if (e < 256) { i = e >> 3; off = h * 64 + (e & 7) * 8; ldsoff = i * 128 + (e & 7) * 16; }
                else if (e < 768) { const int f = e - 256; i = f >> 4; off = 1024 + grp * 128 + (f & 15) * 8; ldsoff = 4096 + i * 256 + (f & 15) * 16; }
                else { const int f = e - 768; i = f >> 4; off = 1536 + grp * 128 + (f & 15) * 8; ldsoff = 4096 + 8192 + i * 256 + (f & 15) * 16; }
                const int ps = dir ? (n - 1 - (blk + i)) : (blk + i);
                *(u32x4*)(F.ldsg + ldsoff) = *(const u32x4*)(xact + (size_t)(base + ps) * 2048 + off);
            }
            if (F.tid < 32) { const int ps = dir ? (n - 1 - (blk + F.tid)) : (blk + F.tid); sdt[F.tid] = F.dt()[(size_t)(base + ps) * 32 + dir * 16 + h]; }
            __syncthreads();
            for (int i = 0; i < 32; ++i) {
                const float dtv = sdt[i], dec = __expf(dtv * a), xv = bf2f(sx[i * 64 + p]) * dtv;
                const u32x4 b0 = *(const u32x4*)(sB + i * 128 + nq * 16), b1 = *(const u32x4*)(sB + i * 128 + nq * 16 + 8);
                const u32x4 c0 = *(const u32x4*)(sC + i * 128 + nq * 16), c1 = *(const u32x4*)(sC + i * 128 + nq * 16 + 8);
                const float Bv[16] = {lo2f(b0.x), hi2f(b0.x), lo2f(b0.y), hi2f(b0.y), lo2f(b0.z), hi2f(b0.z), lo2f(b0.w), hi2f(b0.w), lo2f(b1.x), hi2f(b1.x), lo2f(b1.y), hi2f(b1.y), lo2f(b1.z), hi2f(b1.z), lo2f(b1.w), hi2f(b1.w)};
                const float Cv[16] = {lo2f(c0.x), hi2f(c0.x), lo2f(c0.y), hi2f(c0.y), lo2f(c0.z), hi2f(c0.z), lo2f(c0.w), hi2f(c0.w), lo2f(c1.x), hi2f(c1.x), lo2f(c1.y), hi2f(c1.y), lo2f(c1.z), hi2f(c1.z), lo2f(c1.w), hi2f(c1.w)};
                float yp = 0.f;
#pragma unroll
                for (int q = 0; q < 16; ++q) { st[q] = dec * st[q] + xv * Bv[q]; yp += Cv[q] * st[q]; }
                yp += xsw<1>(yp); yp += xsw<2>(yp); yp += xsw<4>(yp);
                if (nq == 0) sy[i * 64 + p] = yp;
            }
            __syncthreads();
            { const int i = F.tid >> 4, p4 = (F.tid & 15) * 4; const int ps = dir ? (n - 1 - (blk + i)) : (blk + i);
              u32x2 w; w.x = pack2(sy[i * 64 + p4], sy[i * 64 + p4 + 1]); w.y = pack2(sy[i * 64 + p4 + 2], sy[i * 64 + p4 + 3]);
              *(u32x2*)(yout + (size_t)(base + ps) * 1024 + h * 64 + p4) = w; }
        }
    }
}

__device__ __forceinline__ void gla_chain(Frame& F, int l, int b, int h, int dir, int vs) {
    const int vv = F.tid & 63, kg = F.tid >> 6;
    float* sq = (float*)F.ldsg;
    float* sk = sq + 2048;
    float* se = sk + 2048;
    float* sv = se + 2048;
    float* swg = sv + 1024;
    float* sbg = swg + 2048;
    float* sgl = sbg + 128;
    float* sop = sgl + 256;
    bf16_t* oout = F.og() + (size_t)dir * MR * 1024;
    __syncthreads();
    for (int e = F.tid; e < 2048; e += 512) { const int r = e >> 7, c = e & 127; swg[e] = F.in[I_GLAWG][(((size_t)l * 2 + dir) * 16 + r) * 512 + h * 128 + c]; }
    if (F.tid < 128) sbg[F.tid] = F.in[I_GLABG][((size_t)l * 2 + dir) * 512 + h * 128 + F.tid];
    float st[16];
#pragma unroll
    for (int i = 0; i < 16; ++i) st[i] = 0.f;
    for (int seg = 0; seg < 2; ++seg) {
        const int n = seg ? SEQ : LCTX, base = seg ? b * SEQ : RX + b * LCTX;
        for (int blk = 0; blk < n; blk += 16) {
            __syncthreads();
            if (F.tid < 256) { const int i = F.tid >> 4, r = F.tid & 15; const int ps = dir ? (n - 1 - (blk + i)) : (blk + i); sgl[F.tid] = F.glr()[(size_t)(base + ps) * 32 + dir * 16 + r]; }
            for (int e = F.tid; e < 2048; e += 512) { const int i = e >> 7, c = e & 127; const int ps = dir ? (n - 1 - (blk + i)) : (blk + i); const bf16_t* rp = F.p1() + (size_t)(base + ps) * P1W;
                sq[e] = bf2f(rp[C_GQ + h * 128 + c]) * 0.08838834764831845f; sk[e] = bf2f(rp[C_GK + h * 128 + c]); }
            for (int e = F.tid; e < 1024; e += 512) { const int i = e >> 6, c = e & 63; const int ps = dir ? (n - 1 - (blk + i)) : (blk + i); sv[e] = bf2f(F.p1()[(size_t)(base + ps) * P1W + C_GV + h * 256 + vs * 64 + c]); }
            __syncthreads();
            for (int e = F.tid; e < 2048; e += 512) { const int i = e >> 7, c = e & 127; float lg = sbg[c];
#pragma unroll
                for (int r = 0; r < 16; ++r) lg += sgl[i * 16 + r] * swg[r * 128 + c];
                const float ls = fminf(lg, 0.f) - log1pf(__expf(-fabsf(lg)));
                se[e] = __expf(ls * (1.f / 16.f)); }
            __syncthreads();
            for (int i = 0; i < 16; ++i) {
                const float vval = sv[i * 64 + vv]; float o = 0.f;
#pragma unroll
                for (int q4 = 0; q4 < 4; ++q4) { const f32x4 e4 = *(const f32x4*)(se + i * 128 + kg * 16 + q4 * 4), k4 = *(const f32x4*)(sk + i * 128 + kg * 16 + q4 * 4), qq = *(const f32x4*)(sq + i * 128 + kg * 16 + q4 * 4);
#pragma unroll
                    for (int j = 0; j < 4; ++j) { st[q4 * 4 + j] = e4[j] * st[q4 * 4 + j] + k4[j] * vval; o += qq[j] * st[q4 * 4 + j]; } }
                sop[(i * 8 + kg) * 64 + vv] = o;
            }
            __syncthreads();
            for (int e = F.tid; e < 1024; e += 512) { const int i = e >> 6, c = e & 63; float s = 0.f;
#pragma unroll
                for (int q = 0; q < 8; ++q) s += sop[(i * 8 + q) * 64 + c];
                const int ps = dir ? (n - 1 - (blk + i)) : (blk + i);
                oout[(size_t)(base + ps) * 1024 + h * 256 + vs * 64 + c] = f2bf(s); }
        }
    }
}

template <int NSLOT, class KF>
__device__ __forceinline__ void wave_attn(const bf16_t* qp, int nkeys, const KF& kf, bool has_sink, float sink, bf16_t* outp, int lane) {
    bf8_t q[8];
#pragma unroll
    for (int i = 0; i < 8; ++i) q[i] = *(const bf8_t*)(qp + i * 8);
    float lg[NSLOT]; float m = has_sink ? sink : -1e30f;
#pragma unroll
    for (int s = 0; s < NSLOT; ++s) {
        const int i = s * 64 + lane; float v = -1e30f;
        if (i < nkeys) { const bf16_t* kp; const bf16_t* vp; float bias;
            if (kf.key(i, kp, vp, bias)) { float d = 0.f;
#pragma unroll
                for (int c = 0; c < 8; ++c) { const bf8_t kw = *(const bf8_t*)(kp + c * 8);
                    d = __builtin_amdgcn_fdot2_f32_bf16(__builtin_shufflevector(q[c], q[c], 0, 1), __builtin_shufflevector(kw, kw, 0, 1), d, false);
                    d = __builtin_amdgcn_fdot2_f32_bf16(__builtin_shufflevector(q[c], q[c], 2, 3), __builtin_shufflevector(kw, kw, 2, 3), d, false);
                    d = __builtin_amdgcn_fdot2_f32_bf16(__builtin_shufflevector(q[c], q[c], 4, 5), __builtin_shufflevector(kw, kw, 4, 5), d, false);
                    d = __builtin_amdgcn_fdot2_f32_bf16(__builtin_shufflevector(q[c], q[c], 6, 7), __builtin_shufflevector(kw, kw, 6, 7), d, false); }
                v = d + bias; } }
        lg[s] = v; m = fmaxf(m, v);
    }
    m = wmax(m);
    float sum = 0.f;
#pragma unroll
    for (int s = 0; s < NSLOT; ++s) { const float p = (lg[s] > -1e29f) ? __expf(lg[s] - m) : 0.f; lg[s] = p; sum += p; }
    sum = wsum(sum); if (has_sink) sum += __expf(sink - m);
    float acc = 0.f;
#pragma unroll
    for (int s = 0; s < NSLOT; ++s) {
        const int cnt = (nkeys - s * 64) < 64 ? (nkeys - s * 64) : 64;
        for (int j = 0; j < cnt; ++j) { const float pj = rlane(lg[s], j);
            if (pj != 0.f) { const bf16_t* kp; const bf16_t* vp; float bias; kf.key(s * 64 + j, kp, vp, bias); acc += pj * bf2f(vp[lane]); } }
    }
    outp[lane] = f2bf(acc / sum);
}
struct KfNA { const bf16_t* p1; const float* rpb; int b, r, col, r0, c0, h;
    __device__ __forceinline__ bool key(int i, const bf16_t*& kp, const bf16_t*& vp, float& bias) const {
        if (i < 128) { const int kr = r0 + (i >> 4), kc = c0 + (i & 15); const bf16_t* rp = p1 + (size_t)(b * SEQ + kr * 64 + kc) * P1W + C_NA + h * 64;
            kp = rp + 1024; vp = rp + 2048; bias = rpb[(kr - r + 7) * 31 + (kc - col + 15)]; }
        else { const bf16_t* rp = p1 + (size_t)(RX + b * LCTX + (i - 128)) * P1W + C_NA + h * 64; kp = rp + 1024; vp = rp + 2048; bias = 0.f; }
        return true; } };
struct KfSWA { const bf16_t* p1; int b, lo, nloc, hk;
    __device__ __forceinline__ bool key(int i, const bf16_t*& kp, const bf16_t*& vp, float& bias) const {
        const int row = (i < nloc) ? (b * SEQ + lo + i) : (RX + b * LCTX + (i - nloc)); const bf16_t* rp = p1 + (size_t)row * P1W;
        kp = rp + C_SK + hk * 64; vp = rp + C_SV + hk * 64; bias = 0.f; return true; } };
struct KfCtxNA { const bf16_t* p1; int b, h;
    __device__ __forceinline__ bool key(int i, const bf16_t*& kp, const bf16_t*& vp, float& bias) const {
        const bf16_t* rp = p1 + (size_t)(RX + b * LCTX + i) * P1W + C_NA + h * 64; kp = rp + 1024; vp = rp + 2048; bias = 0.f; return true; } };

#ifndef ATTN_TASK
#define ATTN_TASK attn_task6
#endif
__device__ __forceinline__ void phase_mix(Frame& F, int l, int qslot, int only = 0) {
    const bool need_ctx = (l == 0);
    const int nU = 128 + 256 + 256 + (need_ctx ? 32 : 0);
    bf16_t* bout = F.outs() + 1 * 1024; bf16_t* dout = F.outs() + 3 * 1024;
    float* srpb = (float*)(F.ldsg + 98304);
    float rmax = 0.f;
    for (int e = F.tid; e < 16 * 465; e += 512) { const float v = F.in[I_RPB][(size_t)l * 16 * 465 + e]; srpb[e] = v; rmax = fmaxf(rmax, fabsf(v)); }
    bool rpb_ok = true;
    const float gq = wmax(fabsf(F.in[I_NAQN][l * 64 + F.lane])), gk = wmax(fabsf(F.in[I_NAKN][l * 64 + F.lane]));
    const float sq = wmax(fabsf(F.in[I_SWAQN][l * 64 + F.lane])), sk = wmax(fabsf(F.in[I_SWAKN][l * 64 + F.lane]));
    const float smx = wmax(F.lane < 16 ? F.in[I_SINK][l * 16 + F.lane] : -1e30f);
    rmax = wmax(rmax);
    float* sred = (float*)(F.ldsg + 128064);
    if (F.lane == 0) sred[F.wave] = rmax;
    __syncthreads();
    float rall = 0.f;
#pragma unroll
    for (int w = 0; w < 8; ++w) rall = fmaxf(rall, sred[w]);
    const float L2E = 1.4426950408889634f;
    const float shift_na = (8.2f * gq * gk + rall) * L2E, shift_sw = fmaxf(8.2f * sq * sk, smx) * L2E;
    const int qa = 200 + qslot * 4;
    for (;;) {
        const int u = next_unit(F, qslot);
        if (u >= 128) break;
        F.refresh(F.ws0);
        if (only >= 2) continue;
        if (u < 64) chain_mfma<1>(F, l, u >> 4, (u >> 2) & 3, (u >> 1) & 1, u & 1);
        else { const int v = u - 64; chain_ssd2(F, l, v >> 4, (v >> 1) & 7, v & 1); }
        rpb_ok = false;
    }
    if (!rpb_ok) { __syncthreads(); for (int e = F.tid; e < 16 * 465; e += 512) srpb[e] = F.in[I_RPB][(size_t)l * 16 * 465 + e]; __syncthreads(); rpb_ok = true; }
    for (;;) {
        const int v = next_unit(F, qa + 0);
        if (v >= 512) break;
        F.refresh(F.ws0);
        if (only == 1 || only == 4) continue;
        const int b = v >> 7, h = (v >> 3) & 15, rb = v & 7;
        attn_task4<0>(F, l, b, h, rb * 8 + F.wave, srpb + h * 465, shift_na, nullptr, bout, F.lane);
    }
    for (;;) {
        const int v = next_unit(F, qa + 1);
        if (v >= 512) break;
        F.refresh(F.ws0);
        if (only == 1 || only == 3) continue;
        const int b = v >> 7, kvh = (v >> 5) & 3, tb = v & 31;
        attn_task4<1>(F, l, b, kvh, tb * 8 + F.wave, srpb, shift_sw, F.in[I_SINK] + l * 16, dout, F.lane);
    }
    if (need_ctx) for (;;) {
        const int v = next_unit(F, qa + 2);
        if (v >= 32) break;
        F.refresh(F.ws0);
        if (only == 1 || only >= 3) continue;
        const int swa = v >> 4, b = (v >> 2) & 3, qd = v & 3;
#pragma unroll 1
        for (int t = F.wave; t < 16; t += 8) {
            if (!swa) attn_task4<2>(F, l, b, t, qd, srpb, shift_na, nullptr, bout, F.lane);
            else attn_task4<3>(F, l, b, t >> 2, qd * 4 + (t & 3), srpb, shift_sw, F.in[I_SINK] + l * 16, dout, F.lane); }
    }
}

__device__ __forceinline__ void phase_fin(Frame& F, int l, int nrows) {
    const bf16_t* xact = F.hn(); const bf16_t* yf = F.ys(); const bf16_t* yb = F.ys() + (size_t)MR * 1024; const bf16_t* of = F.og(); const bf16_t* ob = F.og() + (size_t)MR * 1024;
    bf16_t* aout = F.outs(); bf16_t* cout = F.outs() + 2 * 1024;
    for (int row = F.bid * 8 + F.wave; row < nrows; row += F.G * 8) {
        float y[16]; float ss = 0.f;
#pragma unroll
        for (int j = 0; j < 4; ++j) { const int c = j * 256 + F.lane * 4; const float dsk = F.in[I_SSDD][l * 16 + (c >> 6)];
            const u32x2 a = *(const u32x2*)(yf + (size_t)row * 1024 + c), bq = *(const u32x2*)(yb + (size_t)row * 1024 + c), xs = *(const u32x2*)(xact + (size_t)row * 2048 + c), z = *(const u32x2*)(F.p1() + (size_t)row * P1W + C_Z + c);
            y[j * 4 + 0] = (lo2f(a.x) + lo2f(bq.x) + dsk * lo2f(xs.x)) * siluf(lo2f(z.x)); y[j * 4 + 1] = (hi2f(a.x) + hi2f(bq.x) + dsk * hi2f(xs.x)) * siluf(hi2f(z.x));
            y[j * 4 + 2] = (lo2f(a.y) + lo2f(bq.y) + dsk * lo2f(xs.y)) * siluf(lo2f(z.y)); y[j * 4 + 3] = (hi2f(a.y) + hi2f(bq.y) + dsk * hi2f(xs.y)) * siluf(hi2f(z.y));
#pragma unroll
            for (int e = 0; e < 4; ++e) ss += y[j * 4 + e] * y[j * 4 + e]; }
        ss = wsum(ss); const float r = rsqrtf(ss * (1.f / 1024.f) + EPS);
#pragma unroll
        for (int j = 0; j < 4; ++j) { const int c = j * 256 + F.lane * 4; const f32x4 g = *(const f32x4*)(F.in[I_SSDNG] + (size_t)l * 1024 + c);
            u32x2 w; w.x = pack2(y[j * 4] * r * g[0], y[j * 4 + 1] * r * g[1]); w.y = pack2(y[j * 4 + 2] * r * g[2], y[j * 4 + 3] * r * g[3]); *(u32x2*)(aout + (size_t)row * 4096 + c) = w; }
#pragma unroll
        for (int j = 0; j < 4; ++j) { const int c = j * 256 + F.lane * 4;
            const u32x2 a = *(const u32x2*)(of + (size_t)row * 1024 + c), bq = *(const u32x2*)(ob + (size_t)row * 1024 + c), rr = *(const u32x2*)(F.p1() + (size_t)row * P1W + C_GR + c);
            const float o0 = lo2f(a.x) + lo2f(bq.x), o1 = hi2f(a.x) + hi2f(bq.x), o2 = lo2f(a.y) + lo2f(bq.y), o3 = hi2f(a.y) + hi2f(bq.y);
            float s2 = o0 * o0 + o1 * o1 + o2 * o2 + o3 * o3; s2 = wsum(s2); const float rn = rsqrtf(s2 * (1.f / 256.f) + EPS);
            const f32x4 g = *(const f32x4*)(F.in[I_GLANG] + (size_t)l * 256 + F.lane * 4);
            u32x2 w; w.x = pack2(o0 * rn * g[0] * siluf(lo2f(rr.x)), o1 * rn * g[1] * siluf(hi2f(rr.x))); w.y = pack2(o2 * rn * g[2] * siluf(lo2f(rr.y)), o3 * rn * g[3] * siluf(hi2f(rr.y)));
            *(u32x2*)(cout + (size_t)row * 4096 + c) = w; }
    }
}

template <int MODE>
__device__ __forceinline__ void ctx_gemm(Frame& F, int l, const float* ci, const float* modl) {
    constexpr int K = (MODE == 0) ? 4096 : 2048, NT = K / 64, SA = 0, SB = 2 * 128 * 144;
    LAS unsigned char* L = F.lds;
    const int tid = F.tid, lane = F.lane, wave = F.wave, g = lane >> 4, i16 = lane & 15, wm = wave >> 1, wn = wave & 1;
    const bf16_t* A = (MODE == 0) ? F.outs() : (MODE == 1) ? F.mb() : F.hn();
    const bf16_t* Bt = (MODE == 0) ? F.wbr() : (MODE == 1) ? F.wout() : (MODE == 2) ? F.wq() : F.win() + (size_t)18944 * DM;
    const int lr = tid >> 3, lc = (tid & 7) * 8;
    for (int u = F.bid; u < ((MODE == 3) ? MR / 128 : 256); u += F.G) {
        const int mt = (MODE == 3) ? u : (u >> 5), nt = (MODE == 3) ? 0 : (u & 31), row0 = ((MODE == 3) ? 0 : RX) + mt * 128, col0 = nt * 64;
        const bf16_t* ap = A + (size_t)(row0 + lr) * K + lc; const bf16_t* bp = Bt + (size_t)(col0 + lr) * K + lc;
        constexpr int RD = 8;
        u32x4 ra0[RD], ra1[RD], rb[RD];
#pragma unroll
        for (int j = 0; j < RD; ++j) { ra0[j] = *(const u32x4*)(ap + j * 64); ra1[j] = *(const u32x4*)(ap + (size_t)64 * K + j * 64); rb[j] = *(const u32x4*)(bp + j * 64); }
        f32x4 acc[2][2], tot[2][2];
#pragma unroll
        for (int mi = 0; mi < 2; ++mi)
#pragma unroll
            for (int ni = 0; ni < 2; ++ni) { acc[mi][ni] = (f32x4){0.f, 0.f, 0.f, 0.f}; tot[mi][ni] = (f32x4){0.f, 0.f, 0.f, 0.f}; }
        __syncthreads();
#pragma unroll 1
        for (int t0 = 0; t0 < NT; t0 += RD) {
#pragma unroll
          for (int j = 0; j < RD; ++j) { const int t = t0 + j;
            LAS unsigned char* as = L + SA + (j & 1) * 128 * 144; LAS unsigned char* bs = L + SB + (j & 1) * 64 * 144;
            *(LAS u32x4*)(as + lr * 144 + lc * 2) = ra0[j]; *(LAS u32x4*)(as + (lr + 64) * 144 + lc * 2) = ra1[j]; *(LAS u32x4*)(bs + lr * 144 + lc * 2) = rb[j];
            if (t + RD < NT) { ra0[j] = *(const u32x4*)(ap + (t + RD) * 64); ra1[j] = *(const u32x4*)(ap + (size_t)64 * K + (t + RD) * 64); rb[j] = *(const u32x4*)(bp + (t + RD) * 64); }
            lds_barrier();
#pragma unroll
            for (int kk = 0; kk < 2; ++kk) { bf16x8 af[2], bfr[2];
#pragma unroll
                for (int mi = 0; mi < 2; ++mi) af[mi] = row_frag(as, 144, wm * 32 + mi * 16 + i16, kk * 64 + g * 16);
#pragma unroll
                for (int ni = 0; ni < 2; ++ni) bfr[ni] = row_frag(bs, 144, wn * 32 + ni * 16 + i16, kk * 64 + g * 16);
#pragma unroll
                for (int mi = 0; mi < 2; ++mi)
#pragma unroll
                    for (int ni = 0; ni < 2; ++ni) acc[mi][ni] = __builtin_amdgcn_mfma_f32_16x16x32_bf16(bfr[ni], af[mi], acc[mi][ni], 0, 0, 0); }
            if (MODE == 0) { if ((t & 15) == 15) { const int br = t >> 4;
#pragma unroll
                for (int mi = 0; mi < 2; ++mi)
#pragma unroll
                    for (int ni = 0; ni < 2; ++ni) { const int row = row0 + wm * 32 + mi * 16 + i16, col = col0 + wn * 32 + ni * 16 + 4 * g;
                        const int ri = row & 255, ci_ = col & 255;
                        const unsigned gw = *(const unsigned*)((const unsigned char*)F.g() + pg8::gate_frag((row >> 8) * 32 + br * 8 + (col >> 8), ri >> 7, (ri & 63) >> 4, ci_ >> 7, ((ri & 127) >> 6) * 4 + ((ci_ & 127) >> 5), ((ci_ & 31) >> 3) * 16 + (ri & 15)) + (ci_ & 7));
#pragma unroll
                        for (int j = 0; j < 4; ++j) tot[mi][ni][j] += (float)((gw >> (8 * j)) & 255u) * (1.f / 255.f) * acc[mi][ni][j];
                        acc[mi][ni] = (f32x4){0.f, 0.f, 0.f, 0.f}; } } }
          }
        }
#pragma unroll
        for (int mi = 0; mi < 2; ++mi)
#pragma unroll
            for (int ni = 0; ni < 2; ++ni) { const int row = row0 + wm * 32 + mi * 16 + i16, col = col0 + wn * 32 + ni * 16 + 4 * g;
                if (MODE == 0) { u32x2 w; w.x = pg8::cvt_pk_bf16(tot[mi][ni][0], tot[mi][ni][1]); w.y = pg8::cvt_pk_bf16(tot[mi][ni][2], tot[mi][ni][3]); *(u32x2*)(F.mb() + (size_t)row * DM + col) = w; }
                else if (MODE == 1) { const f32x4 gt = *(const f32x4*)(modl + ((size_t)4 * 6 + 2) * DM + col); const f32x4 v = gt * acc[mi][ni];
                    u32x2 w; w.x = pg8::cvt_pk_bf16(v[0], v[1]); w.y = pg8::cvt_pk_bf16(v[2], v[3]); *(u32x2*)(F.ys() + (size_t)row * DM + col) = w; }
                else if (MODE == 2) { u32x2 w; w.x = pg8::cvt_pk_bf16(acc[mi][ni][0], acc[mi][ni][1]); w.y = pg8::cvt_pk_bf16(acc[mi][ni][2], acc[mi][ni][3]); *(u32x2*)((bf16_t*)F.qp() + (size_t)row * DM + col) = w; }
                else { float* dst = (col < 32) ? F.dtr() + (size_t)row * 32 + col : F.glr() + (size_t)row * 32 + (col - 32); *(f32x4*)dst = acc[mi][ni]; } }
    }
    __syncthreads();
}
__device__ __forceinline__ unsigned ford(float f) { const unsigned u = __float_as_uint(f); return (u & 0x80000000u) ? ~u : (u | 0x80000000u); }
__device__ __forceinline__ float funord(unsigned k) { const unsigned u = (k & 0x80000000u) ? (k & 0x7fffffffu) : ~k; return __uint_as_float(u); }
__device__ __forceinline__ void phase_topk_search(Frame& F, int l, int nrows) {
    bf16_t* k1b = (bf16_t*)F.ldsg;
    bf16_t* k2b = k1b + 128 * 136;
    float* cval = (float*)(F.ldsg + 69632) + F.wave * 1024;
    int* cidx = (int*)cval + 512;
    __syncthreads();
    for (int e = F.tid; e < 16384; e += 512) { const int key = e >> 7, d = e & 127; k1b[key * 136 + d] = f2bf(F.in[I_PK1][(size_t)l * 16384 + e]); k2b[key * 136 + d] = f2bf(F.in[I_PK2][(size_t)l * 16384 + e]); }
    __syncthreads();
    const int c = F.lane & 15, g = F.lane >> 4;
    const bf16_t* qb = (const bf16_t*)F.qp();
    const int ntask = (nrows / 16) * 8;
    for (int t = F.bid * 8 + F.wave; t < ntask; t += F.G * 8) {
        const int tile = t >> 3, h = t & 7, row = tile * 16 + c;
#pragma unroll
        for (int side = 0; side < 2; ++side) {
            const bf16_t* kb = side ? k2b : k1b;
            bf16x8 qf[4];
#pragma unroll
            for (int s = 0; s < 4; ++s) qf[s] = *(const bf16x8*)(qb + (size_t)row * DM + h * 256 + side * 128 + 32 * s + 8 * g);
            unsigned key[32];
#pragma unroll
            for (int kt = 0; kt < 8; ++kt) { f32x4 acc = (f32x4){0.f, 0.f, 0.f, 0.f};
#pragma unroll
                for (int s = 0; s < 4; ++s) { const bf16x8 kf = *(const bf16x8*)(kb + (kt * 16 + c) * 136 + 32 * s + 8 * g); acc = __builtin_amdgcn_mfma_f32_16x16x32_bf16(kf, qf[s], acc, 0, 0, 0); }
#pragma unroll
                for (int r = 0; r < 4; ++r) key[kt * 4 + r] = ((ford(acc[r]) >> 1) & ~127u) | (unsigned)(127 - (kt * 16 + 4 * g + r));
                if (kt & 1) __builtin_amdgcn_sched_barrier(0); }
            unsigned pre = 0u;
#pragma unroll 1
            for (int bit = 30; bit >= 0; --bit) { const unsigned cand = pre | (1u << bit); int cnt = 32;
#pragma unroll
                for (int i = 0; i < 32; ++i) cnt += ((int)(key[i] - cand)) >> 31;
                cnt += xswi<16>(cnt); cnt += xswi<32>(cnt);
                pre = (cnt >= 16) ? cand : pre; }
            unsigned sel = 0u;
#pragma unroll
            for (int i = 0; i < 32; ++i) sel |= ~(unsigned)(((int)(key[i] - pre)) >> 31) & (1u << i);
            const int mine = __builtin_popcount(sel);
            const int m16 = xswi<16>(mine); const int s2a = mine + m16; const int s2b = xswi<32>(s2a);
            int pos = ((g & 1) ? m16 : 0) + ((g & 2) ? s2b : 0);
#pragma unroll
            for (int i = 0; i < 32; ++i) if ((sel >> i) & 1u) { const unsigned k7 = key[i] & 127u; cval[(c * 2 + side) * 16 + pos] = funord((key[i] & ~127u) << 1); cidx[(c * 2 + side) * 16 + pos] = 127 - (int)k7; ++pos; }
        }
#pragma unroll 1
        for (int ps = 0; ps < 2; ++ps) {
            const int tk = ps * 8 + (F.lane & 7), sub = F.lane >> 3, row2 = tile * 16 + tk;
            float v1[2], v2[16]; int i1[2];
#pragma unroll
            for (int a = 0; a < 2; ++a) { v1[a] = cval[(tk * 2 + 0) * 16 + 2 * sub + a]; i1[a] = cidx[(tk * 2 + 0) * 16 + 2 * sub + a]; }
#pragma unroll
            for (int bb = 0; bb < 16; ++bb) v2[bb] = cval[(tk * 2 + 1) * 16 + bb];
            unsigned key[32];
#pragma unroll
            for (int a = 0; a < 2; ++a)
#pragma unroll
                for (int bb = 0; bb < 16; ++bb) key[a * 16 + bb] = ((ford(v1[a] + v2[bb]) >> 1) & ~255u) | (unsigned)(255 - ((2 * sub + a) * 16 + bb));
            unsigned pre = 0u;
#pragma unroll 1
            for (int bit = 30; bit >= 0; --bit) { const unsigned cand = pre | (1u << bit); int cnt = 32;
#pragma unroll
                for (int i = 0; i < 32; ++i) cnt += ((int)(key[i] - cand)) >> 31;
                cnt += xswi<8>(cnt); cnt += xswi<16>(cnt); cnt += xswi<32>(cnt);
                pre = (cnt >= 16) ? cand : pre; }
            unsigned sel = 0u;
#pragma unroll
            for (int i = 0; i < 32; ++i) sel |= ~(unsigned)(((int)(key[i] - pre)) >> 31) & (1u << i);
            const int mine = __builtin_popcount(sel);
            float mx = -1e30f;
#pragma unroll
            for (int a = 0; a < 2; ++a)
#pragma unroll
                for (int bb = 0; bb < 16; ++bb) { const float sv = v1[a] + v2[bb]; mx = ((sel >> (a * 16 + bb)) & 1u) ? fmaxf(mx, sv) : mx; }
            mx = fmaxf(mx, xsw<8>(mx)); mx = fmaxf(mx, xsw<16>(mx)); mx = fmaxf(mx, xsw<32>(mx));
            float es = 0.f;
#pragma unroll
            for (int a = 0; a < 2; ++a)
#pragma unroll
                for (int bb = 0; bb < 16; ++bb) { const float ev = __expf(v1[a] + v2[bb] - mx); es += ((sel >> (a * 16 + bb)) & 1u) ? ev : 0.f; }
            es += xsw<8>(es); es += xsw<16>(es); es += xsw<32>(es);
            const float inv = 1.f / es;
            const int c8 = xswi<8>(mine); const int p2 = mine + c8; const int c16 = xswi<16>(p2); const int p4 = p2 + c16; const int c32 = xswi<32>(p4);
            int pos = ((sub & 1) ? c8 : 0) + ((sub & 2) ? c16 : 0) + ((sub & 4) ? c32 : 0);
            int* ip = F.idx() + (size_t)row2 * 128 + h * 16; float* gp = F.gate() + (size_t)row2 * 128 + h * 16;
            unsigned m = sel;
            while (m) { const int bi = __builtin_ctz(m); m &= m - 1u; const int a = bi >> 4, bb = bi & 15;
                const float va = a ? v1[1] : v1[0]; const int ia = a ? i1[1] : i1[0];
                ip[pos] = ia * 128 + cidx[(tk * 2 + 1) * 16 + bb]; gp[pos] = __expf(va + cval[(tk * 2 + 1) * 16 + bb] - mx) * inv; ++pos; }
        }
    }
    __syncthreads();
}

#define TK_CE(x, i, j) { const unsigned _a = x[i], _b = x[j]; x[i] = _a > _b ? _a : _b; x[j] = _a > _b ? _b : _a; }
#define TK_SORT16(x) do { TK_CE(x, 0, 1); TK_CE(x, 2, 3); TK_CE(x, 0, 2); TK_CE(x, 1, 3); TK_CE(x, 1, 2); TK_CE(x, 4, 5); TK_CE(x, 6, 7); TK_CE(x, 4, 6); TK_CE(x, 5, 7); TK_CE(x, 5, 6); TK_CE(x, 0, 4); TK_CE(x, 2, 6); TK_CE(x, 2, 4); TK_CE(x, 1, 5); TK_CE(x, 3, 7); TK_CE(x, 3, 5); TK_CE(x, 1, 2); TK_CE(x, 3, 4); TK_CE(x, 5, 6); TK_CE(x, 8, 9); TK_CE(x, 10, 11); TK_CE(x, 8, 10); TK_CE(x, 9, 11); TK_CE(x, 9, 10); TK_CE(x, 12, 13); TK_CE(x, 14, 15); TK_CE(x, 12, 14); TK_CE(x, 13, 15); TK_CE(x, 13, 14); TK_CE(x, 8, 12); TK_CE(x, 10, 14); TK_CE(x, 10, 12); TK_CE(x, 9, 13); TK_CE(x, 11, 15); TK_CE(x, 11, 13); TK_CE(x, 9, 10); TK_CE(x, 11, 12); TK_CE(x, 13, 14); TK_CE(x, 0, 8); TK_CE(x, 4, 12); TK_CE(x, 4, 8); TK_CE(x, 2, 10); TK_CE(x, 6, 14); TK_CE(x, 6, 10); TK_CE(x, 2, 4); TK_CE(x, 6, 8); TK_CE(x, 10, 12); TK_CE(x, 1, 9); TK_CE(x, 5, 13); TK_CE(x, 5, 9); TK_CE(x, 3, 11); TK_CE(x, 7, 15); TK_CE(x, 7, 11); TK_CE(x, 3, 5); TK_CE(x, 7, 9); TK_CE(x, 11, 13); TK_CE(x, 1, 2); TK_CE(x, 3, 4); TK_CE(x, 5, 6); TK_CE(x, 7, 8); TK_CE(x, 9, 10); TK_CE(x, 11, 12); TK_CE(x, 13, 14); } while (0)
#define TK_BMERGE16(x) do { TK_CE(x, 0, 8); TK_CE(x, 1, 9); TK_CE(x, 2, 10); TK_CE(x, 3, 11); TK_CE(x, 4, 12); TK_CE(x, 5, 13); TK_CE(x, 6, 14); TK_CE(x, 7, 15); TK_CE(x, 0, 4); TK_CE(x, 1, 5); TK_CE(x, 2, 6); TK_CE(x, 3, 7); TK_CE(x, 8, 12); TK_CE(x, 9, 13); TK_CE(x, 10, 14); TK_CE(x, 11, 15); TK_CE(x, 0, 2); TK_CE(x, 1, 3); TK_CE(x, 4, 6); TK_CE(x, 5, 7); TK_CE(x, 8, 10); TK_CE(x, 9, 11); TK_CE(x, 12, 14); TK_CE(x, 13, 15); TK_CE(x, 0, 1); TK_CE(x, 2, 3); TK_CE(x, 4, 5); TK_CE(x, 6, 7); TK_CE(x, 8, 9); TK_CE(x, 10, 11); TK_CE(x, 12, 13); TK_CE(x, 14, 15); } while (0)
template <int X> __device__ __forceinline__ void tk_xmerge(unsigned (&T)[16], int xaddr) {
    unsigned M[16];
#pragma unroll
    for (int i = 0; i < 16; ++i) { const unsigned p = (X == 16) ? (unsigned)xswi<16>((int)T[15 - i]) : (unsigned)__builtin_amdgcn_ds_bpermute(xaddr, (int)T[15 - i]); M[i] = T[i] > p ? T[i] : p; }
    TK_BMERGE16(M);
#pragma unroll
    for (int i = 0; i < 16; ++i) T[i] = M[i];
}
__device__ __forceinline__ void phase_topk(Frame& F, int l, int nrows) {
    bf16_t* k1b = (bf16_t*)F.ldsg;
    bf16_t* k2b = k1b + 128 * 136;
    float* cval = (float*)(F.ldsg + 69632) + F.wave * 1024;
    int* cidx = (int*)cval + 512;
    unsigned char* ptab = F.ldsg + 102400;
    __syncthreads();
    for (int e = F.tid; e < 16384; e += 512) { const int key = e >> 7, d = e & 127; k1b[key * 136 + d] = f2bf(F.in[I_PK1][(size_t)l * 16384 + e]); k2b[key * 136 + d] = f2bf(F.in[I_PK2][(size_t)l * 16384 + e]); }
    if (F.tid < 64) { int pa = 0xff, idx = 0;
        for (int a = 0; a < 16; ++a) for (int b = 0; b < 16 / (a + 1); ++b) { if (idx == F.tid) pa = a | (b << 4); ++idx; }
        ptab[F.tid] = (unsigned char)pa; }
    __syncthreads();
    const int c = F.lane & 15, g = F.lane >> 4, xaddr = (F.lane ^ 32) << 2;
    unsigned pt[13];
#pragma unroll
    for (int k = 0; k < 13; ++k) pt[k] = ptab[k * 4 + g];
    const bf16_t* qb = (const bf16_t*)F.qp();
    const int ntask = (nrows / 16) * 8;
    for (int t = F.bid * 8 + F.wave; t < ntask; t += F.G * 8) {
        const int tile = t >> 3, h = t & 7, row = tile * 16 + c;
#pragma unroll
        for (int side = 0; side < 2; ++side) {
            const bf16_t* kb = side ? k2b : k1b;
            bf16x8 qf[4];
#pragma unroll
            for (int s = 0; s < 4; ++s) qf[s] = *(const bf16x8*)(qb + (size_t)row * DM + h * 256 + side * 128 + 32 * s + 8 * g);
            unsigned key[32];
#pragma unroll
            for (int kt = 0; kt < 8; ++kt) { f32x4 acc = (f32x4){0.f, 0.f, 0.f, 0.f};
#pragma unroll
                for (int s = 0; s < 4; ++s) { const bf16x8 kf = *(const bf16x8*)(kb + (kt * 16 + c) * 136 + 32 * s + 8 * g); acc = __builtin_amdgcn_mfma_f32_16x16x32_bf16(kf, qf[s], acc, 0, 0, 0); }
#pragma unroll
                for (int r = 0; r < 4; ++r) key[kt * 4 + r] = ((ford(acc[r]) >> 1) & ~127u) | (unsigned)(127 - (kt * 16 + 4 * g + r));
                if (kt & 1) __builtin_amdgcn_sched_barrier(0); }
            TK_SORT16(key); TK_SORT16((key + 16));
            unsigned T[16];
#pragma unroll
            for (int i = 0; i < 16; ++i) T[i] = key[i] > key[31 - i] ? key[i] : key[31 - i];
            TK_BMERGE16(T);
            tk_xmerge<16>(T, xaddr); tk_xmerge<32>(T, xaddr);
            if (g == 0) {
#pragma unroll
                for (int q = 0; q < 4; ++q) { f32x4 v; u32x4 ix;
#pragma unroll
                    for (int e = 0; e < 4; ++e) { v[e] = funord((T[q * 4 + e] & ~127u) << 1); ix[e] = 127u - (T[q * 4 + e] & 127u); }
                    *(f32x4*)(cval + (c * 2 + side) * 16 + q * 4) = v; *(u32x4*)(cidx + (c * 2 + side) * 16 + q * 4) = ix; } }
        }
        unsigned k2[16];
#pragma unroll
        for (int k = 0; k < 13; ++k) { const int a = pt[k] & 15, b = (pt[k] >> 4) & 15; const float s = cval[(c * 2 + 0) * 16 + a] + cval[(c * 2 + 1) * 16 + b];
            k2[k] = (pt[k] != 0xffu) ? (((ford(s) >> 1) & ~63u) | (unsigned)(63 - (k * 4 + g))) : 0u; }
        k2[13] = 0u; k2[14] = 0u; k2[15] = 0u;
        TK_SORT16(k2);
        tk_xmerge<16>(k2, xaddr); tk_xmerge<32>(k2, xaddr);
        const unsigned p0 = ptab[63 - (k2[0] & 63u)];
        const float mx = cval[(c * 2 + 0) * 16 + (p0 & 15)] + cval[(c * 2 + 1) * 16 + (p0 >> 4)];
        f32x4 ev; u32x4 idv; float es = 0.f;
#pragma unroll
        for (int r = 0; r < 4; ++r) { const unsigned w = (g == 0) ? k2[r] : (g == 1) ? k2[4 + r] : (g == 2) ? k2[8 + r] : k2[12 + r];
            const unsigned p = ptab[63 - (w & 63u)]; const int a = p & 15, b = p >> 4;
            ev[r] = __expf(cval[(c * 2 + 0) * 16 + a] + cval[(c * 2 + 1) * 16 + b] - mx); es += ev[r];
            idv[r] = (unsigned)(cidx[(c * 2 + 0) * 16 + a] * 128 + cidx[(c * 2 + 1) * 16 + b]); }
        es += xsw<16>(es); es += xsw<32>(es);
        const float inv = 1.f / es;
        *(u32x4*)(F.idx() + (size_t)row * 128 + h * 16 + 4 * g) = idv;
        *(f32x4*)(F.gate() + (size_t)row * 128 + h * 16 + 4 * g) = ev * inv;
    }
    __syncthreads();
}

__device__ __forceinline__ void phase_cvt_uv(Frame& F, int l) {
    unsigned char* gb = (unsigned char*)F.g();
    constexpr int NR = 2 * NEXP;
    auto load_row = [&](int r_, f32x4 (&x)[8]) { const int r = min(r_, NR - 1); const bool isv = r >= NEXP; const int e = isv ? r - NEXP : r;
        const float* src = F.in[isv ? I_PV : I_PU] + ((size_t)l * NEXP + e) * DM;
#pragma unroll
        for (int i = 0; i < 2; ++i)
#pragma unroll
            for (int q = 0; q < 4; ++q) x[i * 4 + q] = __builtin_nontemporal_load((const f32x4*)(src + i * 1024 + F.lane * 16 + q * 4)); };
    auto store_row = [&](int r, const f32x4 (&x)[8]) { const bool isv = r >= NEXP; const int e = isv ? r - NEXP : r; float mx = 0.f;
#pragma unroll
        for (int i = 0; i < 8; ++i) mx = fmaxf(mx, fmaxf(fmaxf(fabsf(x[i][0]), fabsf(x[i][1])), fmaxf(fabsf(x[i][2]), fabsf(x[i][3]))));
        mx = wmax(mx);
        const float qm = 127.f;
        const float sc = (mx > 0.f) ? qm / mx : 1.f, isc = (mx > 0.f) ? mx / qm : 1.f;
        unsigned char* dst = gb + (isv ? PE_V8 : PE_U8) + (size_t)e * DM;
#pragma unroll
        for (int i = 0; i < 2; ++i) { u32x4 w;
#pragma unroll
            for (int q = 0; q < 4; ++q) {
                { const int q0 = (int)__builtin_rintf(x[i * 4 + q][0] * sc), q1 = (int)__builtin_rintf(x[i * 4 + q][1] * sc), q2 = (int)__builtin_rintf(x[i * 4 + q][2] * sc), q3 = (int)__builtin_rintf(x[i * 4 + q][3] * sc);
                    w[q] = (unsigned)(q0 & 255) | ((unsigned)(q1 & 255) << 8) | ((unsigned)(q2 & 255) << 16) | ((unsigned)q3 << 24); } }
            *(u32x4*)(dst + i * 1024 + F.lane * 16) = w; }
        if (F.lane == 0) *(float*)(gb + (isv ? PE_SV : PE_SU) + (size_t)e * 4) = isc; };
    f32x4 xa[8], xb[8];
    const int st = F.G * 8;
    int r = F.bid * 8 + F.wave;
    if (r >= NR) return;
    load_row(r, xa);
#pragma unroll 1
    for (; r < NR; r += 2 * st) {
        load_row(r + st, xb);
        store_row(r, xa);
        load_row(r + 2 * st, xa);
        if (r + st < NR) store_row(r + st, xb);
    }
}
constexpr int PG_NS = 16, PG_CH = 64, PG_NCHMAX = MR / PG_CH;
__device__ __forceinline__ void cvt16(u32x4 w, float (&f)[16]) {
#pragma unroll
    for (int q = 0; q < 4; ++q) { const f32x2 a = __builtin_amdgcn_cvt_pk_f32_fp8((int)w[q], false), b = __builtin_amdgcn_cvt_pk_f32_fp8((int)w[q], true); f[q * 4] = a[0]; f[q * 4 + 1] = a[1]; f[q * 4 + 2] = b[0]; f[q * 4 + 3] = b[1]; } }
template <int X1, int X2, int X3>
__device__ __forceinline__ void bfly16(float (&d)[16], int lane, float& o0, float& o1) {
    const bool b1 = lane & X1, b2 = lane & X2, b3 = lane & X3; float r1[8], r2[4];
#pragma unroll
    for (int i = 0; i < 8; ++i) r1[i] = (b1 ? d[8 + i] : d[i]) + xsw<X1>(b1 ? d[i] : d[8 + i]);
#pragma unroll
    for (int i = 0; i < 4; ++i) r2[i] = (b2 ? r1[4 + i] : r1[i]) + xsw<X2>(b2 ? r1[i] : r1[4 + i]);
    o0 = (b3 ? r2[2] : r2[0]) + xsw<X3>(b3 ? r2[0] : r2[2]); o1 = (b3 ? r2[3] : r2[1]) + xsw<X3>(b3 ? r2[1] : r2[3]);
}
template <int PASS>
__device__ __forceinline__ void phase_peer_slice(Frame& F, int l, int nrows, float* xlat, float* xctx, int qbase, const float* xin_lat = nullptr, const float* xin_ctx = nullptr, const bf16_t* delta = nullptr) {
    const unsigned char* gb = (const unsigned char*)F.g();
    const unsigned char* T8 = gb + (PASS ? PE_V8 : PE_U8);
    float* part = F.mp();
    const int nch = nrows / PG_CH;
    const int xcc = (int)(__builtin_amdgcn_s_getreg((3 << 11) | 20) & 7u);
    const int p8 = F.lane & 7, e8 = F.lane >> 3;
    LAS int* sidx = (LAS int*)F.lds;
    LAS unsigned char* sa8 = F.lds + 32768;
    LAS float* sst = (LAS float*)(F.lds + 32768 + 8192);
    const unsigned char* A8 = (const unsigned char*)F.dt(); const float* AST = F.dtr();
    LAS unsigned char* shq = F.lds + 32768;
    LAS float* shs = (LAS float*)(F.lds + 32768 + 8192);
    for (int so = 0; so < PG_NS; ++so) {
        const int s = (2 * xcc + so) & (PG_NS - 1);
        for (;;) {
            const int ch = next_unit(F, qbase + s);
            if (ch >= nch) break;
            for (int e = F.tid; e < 2048; e += 512) *(LAS u32x4*)(sidx + e * 4) = *(const u32x4*)(F.idx() + (size_t)ch * PG_CH * 128 + e * 4);
            if (PASS == 1) { *(LAS u32x4*)(sa8 + F.tid * 16) = *(const u32x4*)(A8 + (size_t)ch * PG_CH * 128 + F.tid * 16); if (F.tid < 64) sst[F.tid] = AST[ch * PG_CH + F.tid]; }
            if (PASS == 0) { { const int r = F.tid >> 3, c16 = F.tid & 7; *(LAS u32x4*)(shq + r * 128 + c16 * 16) = *(const u32x4*)(gb + PE_HQ + (size_t)(ch * PG_CH + r) * DM + s * 128 + c16 * 16); }
                if (F.tid < 64) shs[F.tid] = *(const float*)(gb + PE_HS + ((size_t)(ch * PG_CH + F.tid) * 16 + s) * 4); }
            __syncthreads();
            u32x4 wA[8], wB[8];
            auto issue = [&](int tk, int hf, u32x4 (&w)[8]) {
#pragma unroll
                for (int i = 0; i < 8; ++i) { const int id = sidx[tk * 128 + 8 * (hf * 8 + i) + e8]; w[i] = *(const u32x4*)(T8 + (size_t)id * DM + s * 128 + p8 * 16); } };
            issue(F.wave, 0, wA);
            auto token = [&](auto LC, int j) { constexpr int LAST = decltype(LC)::value; const int tk = F.wave + 8 * j, row = ch * PG_CH + tk;
                float d[16]; u32x4 hq = (u32x4){0u, 0u, 0u, 0u}; float hsc = 0.f; int acc[16]; unsigned aq[4] = {0u, 0u, 0u, 0u};
                if (PASS == 0) { hq = *(LAS const u32x4*)(shq + tk * 128 + p8 * 16); hsc = shs[tk]; }
                else { hsc = sst[tk];
#pragma unroll
                    for (int q = 0; q < 4; ++q) aq[q] = *(LAS const unsigned*)(sa8 + tk * 128 + (q * 8 + e8) * 4);
#pragma unroll
                    for (int q = 0; q < 16; ++q) acc[q] = 0; }
                auto half = [&](int hf, const u32x4 (&w)[8]) {
                    if (PASS == 0) {
#pragma unroll
                        for (int i = 0; i < 8; ++i) { u32x4 wi = w[i]; asm volatile("" : "+v"(wi));
                            int di = __builtin_amdgcn_sdot4((int)wi.x, (int)hq.x, 0, false); di = __builtin_amdgcn_sdot4((int)wi.y, (int)hq.y, di, false);
                            di = __builtin_amdgcn_sdot4((int)wi.z, (int)hq.z, di, false); di = __builtin_amdgcn_sdot4((int)wi.w, (int)hq.w, di, false); d[hf * 8 + i] = (float)di; }
                    } else {
#pragma unroll
                        for (int g2 = 0; g2 < 2; ++g2) { u32x4 r0 = w[g2 * 4 + 0], r1 = w[g2 * 4 + 1], r2 = w[g2 * 4 + 2], r3 = w[g2 * 4 + 3]; asm volatile("" : "+v"(r0), "+v"(r1), "+v"(r2), "+v"(r3));
                            const int a4 = (int)aq[hf * 2 + g2];
#pragma unroll
                            for (int jd = 0; jd < 4; ++jd) {
                                const unsigned lo01 = __builtin_amdgcn_perm(r1[jd], r0[jd], 0x05010400u), hi01 = __builtin_amdgcn_perm(r1[jd], r0[jd], 0x07030602u);
                                const unsigned lo23 = __builtin_amdgcn_perm(r3[jd], r2[jd], 0x05010400u), hi23 = __builtin_amdgcn_perm(r3[jd], r2[jd], 0x07030602u);
                                const unsigned t0 = __builtin_amdgcn_perm(lo23, lo01, 0x05040100u), t1 = __builtin_amdgcn_perm(lo23, lo01, 0x07060302u);
                                const unsigned t2 = __builtin_amdgcn_perm(hi23, hi01, 0x05040100u), t3 = __builtin_amdgcn_perm(hi23, hi01, 0x07060302u);
                                acc[jd * 4 + 0] = __builtin_amdgcn_sdot4((int)t0, a4, acc[jd * 4 + 0], false); acc[jd * 4 + 1] = __builtin_amdgcn_sdot4((int)t1, a4, acc[jd * 4 + 1], false);
                                acc[jd * 4 + 2] = __builtin_amdgcn_sdot4((int)t2, a4, acc[jd * 4 + 2], false); acc[jd * 4 + 3] = __builtin_amdgcn_sdot4((int)t3, a4, acc[jd * 4 + 3], false); } }
                    } };
                f32x2 xres = (f32x2){0.f, 0.f}, gres = (f32x2){0.f, 0.f}; float* xp = nullptr;
                if (PASS == 1) { const int j0 = ((e8 & 1) ? 8 : 0) + ((e8 & 2) ? 4 : 0) + ((e8 & 4) ? 2 : 0); const int col = s * 128 + p8 * 16 + j0;
                    const bool lat = row < RX; const int jb = lat ? (row >> 12) : 4;
                    xp = (lat ? xlat + (size_t)row * DM : xctx + (size_t)(row - RX) * DM) + col; const float* gp = F.mod() + ((size_t)(l * 5 + jb) * 6 + 5) * DM + col;
                    const float* xi = (lat ? xin_lat + (size_t)row * DM : xin_ctx + (size_t)(row - RX) * DM) + col;
                    const unsigned dw = *(const unsigned*)(delta + (size_t)row * DM + col);
                    xres = *(const f32x2*)xi; xres[0] += lo2f(dw); xres[1] += hi2f(dw); gres = *(const f32x2*)gp; }
                issue(tk, 1, wB);
                asm volatile("" ::: "memory");
                half(0, wA);
                asm volatile("" ::: "memory");
                if (LAST == 0) issue(tk + 8, 0, wA);
                asm volatile("" ::: "memory");
                half(1, wB);
                if (PASS == 0) {
                    float o0, o1; bfly16<1, 2, 4>(d, F.lane, o0, o1);
                    const int i0 = ((p8 & 1) ? 8 : 0) + ((p8 & 2) ? 4 : 0) + ((p8 & 4) ? 2 : 0);
                    float* pp = part + ((size_t)s * MR + row) * 128 + e8;
                    pp[8 * i0] = o0 * hsc; pp[8 * (i0 + 1)] = o1 * hsc;
                } else {
#pragma unroll
                    for (int q = 0; q < 16; ++q) d[q] = (float)acc[q];
                    float o0, o1; bfly16<8, 16, 32>(d, F.lane, o0, o1);
                    const float osc = hsc;
                    xres[0] += gres[0] * o0 * osc; xres[1] += gres[1] * o1 * osc; *(f32x2*)xp = xres;
                }
            };
#pragma unroll 1
            for (int j = 0; j < 7; ++j) token(std::integral_constant<int, 0>{}, j);
            token(std::integral_constant<int, 1>{}, 7);
        }
    }
}
__device__ __forceinline__ void phase_peer_act(Frame& F, int l, int nrows) {
    const unsigned char* gb = (const unsigned char*)F.g(); const float* SU = (const float*)(gb + PE_SU); const float* SV = (const float*)(gb + PE_SV);
    const float* part = F.mp(); unsigned char* A8 = (unsigned char*)F.dt(); float* AST = F.dtr();
    for (int t = F.bid * 8 + F.wave; t < nrows; t += F.G * 8) {
        float a[2];
#pragma unroll
        for (int h = 0; h < 2; ++h) { const size_t i = (size_t)t * 128 + F.lane + 64 * h; float z = 0.f;
#pragma unroll
            for (int s = 0; s < PG_NS; ++s) z += part[(size_t)s * MR * 128 + i];
            const int e = F.idx()[i]; z *= SU[e];
            a[h] = 0.5f * z * (1.f + erff(z * 0.70710678118f)) * F.gate()[i] * SV[e]; }
        const float m = wmax(fmaxf(fabsf(a[0]), fabsf(a[1])));
        const float sc = (m > 0.f) ? 127.f / m : 0.f;
#pragma unroll
        for (int h = 0; h < 2; ++h) { const int k = F.lane + 64 * h, e8 = k & 7, i_ = k >> 3; const int q = (int)__builtin_rintf(a[h] * sc);
            A8[(size_t)t * 128 + ((i_ >> 2) * 8 + e8) * 4 + (i_ & 3)] = (unsigned char)(q & 255); }
        if (F.lane == 0) AST[t] = m * (1.f / 127.f);
    }
}
constexpr int LDS_BYTES = 147456;
constexpr int NPH_L = 13, NPH = 1 + DEPTH * NPH_L;
#ifndef MK_MULTI
#define MK_MULTI 0
#endif

__device__ __forceinline__ bool in_phase(int lo, int hi, int k) { asm volatile("" : "+s"(lo), "+s"(hi)); return lo <= k && k < hi; }
__global__ void __launch_bounds__(512, 2) mega(Params P) {
    extern __shared__ __attribute__((aligned(16))) unsigned char smem[];
    Frame F;
    F.in = P.in; F.in0 = P.in; F.out = P.out; F.ws = P.ws; F.lds = (LAS unsigned char*)smem; F.ldsg = smem;
    F.G = gridDim.x; F.bid = blockIdx.x; F.init_ids(); F.refresh(P.ws);
    const int lo = P.ph_lo, hi = P.ph_hi;
    const bool single = (hi - lo) > 1;
    volatile LAS unsigned* st = (volatile LAS unsigned*)(F.lds + 147424);
    if (F.tid < 4) st[F.tid] = 0u;
    __syncthreads();
    XcdBarrier bar; bar.bar = F.ctl() + CW_BAR; bar.x = 0; bar.st = st;
    if (single) bar = xcd_barrier_post(F.ctl() + CW_BAR, st, F.tid);
#if defined(PH_ONLY)
#define EN(k) ((k) == PH_ONLY)
#elif defined(PH_MASK)
#define EN(k) (((PH_MASK) >> (k)) & 1)
#else
#define EN(k) 1
#endif
#define IN(k) in_phase(lo, hi, (k))
#ifndef REPEAT_KIND
#define REPEAT_KIND -1
#endif
#define RPT(kind) (((kind) == REPEAT_KIND) ? 2 : 1)
#define SEAM(k) do { if (IN(k) && IN((k) + 1)) xcd_barrier_t<false>(bar, F.tid); } while (0)
    for (int rp = 0; rp < RPT(0); ++rp) if (EN(0) && IN(0)) { F.refresh(P.ws); phase_mod(F); }
    if (IN(0) && IN(1)) xcd_barrier_t<true>(bar, F.tid);
    auto layer = [&](auto LC) {
        constexpr int l = decltype(LC)::value;
        const int pb = 1 + l * NPH_L;
        const float* xs = l ? F.out : F.in[I_X]; const float* cs = l ? F.ctxs() : F.in[I_CTX];
        const int nr2 = l ? RX : MR;
        float* modl = F.mod() + (size_t)l * 5 * 6 * DM;
        for (int rp = 0; rp < RPT(1); ++rp) if (EN(1) && IN(pb + 0)) { F.refresh(P.ws); phase_wcvt(F, l); phase_norm(F, l, 0, xs, cs, MR); }
        SEAM(pb + 0);
        for (int rp = 0; rp < RPT(2); ++rp) if (EN(2) && IN(pb + 1)) { F.refresh(P.ws); pg8::Gemm g{F.hn(), F.win(), MR, INP, DM}; pg8::EpiInProj E{F.p1(), (unsigned char*)F.g(), F.dtr(), F.glr()};
            if constexpr (l + 1 < DEPTH) { pg8::StaticOrder S; S.init(MR, INP, F.G, F.bid); pg8::gemm_phase<pg8::EpiInProj, pg8::StaticOrder, true, true>(F.lds, g, S, E, F.tid); }
            else { pg8::TrimOrder S{F.G, F.bid}; pg8::gemm_phase<pg8::EpiInProj, pg8::TrimOrder, true, true>(F.lds, g, S, E, F.tid); F.refresh(P.ws); ctx_gemm<3>(F, l, cs, modl);
                   for (int e = F.bid * 512 + F.tid; e < RC * 640; e += F.G * 512) { const int row = RX + e / 640, q = e % 640;
                       const int col = (q < 128) ? q * 8 : (q < 192) ? 2560 + (q - 128) * 8 : (q < 320) ? 3072 + (q - 192) * 8 : (q < 384) ? 6144 + (q - 320) * 8 : (q < 512) ? 8192 + (q - 384) * 8 : 9216 + (q - 512) * 8;
                       *(u32x4*)(F.p1() + (size_t)row * P1W + col) = (u32x4){0u, 0u, 0u, 0u}; } } }
        SEAM(pb + 1);
        if (EN(3) && IN(pb + 2)) { F.refresh(P.ws); phase_prep(F, l); }
        if (REPEAT_KIND == 3) { if (EN(3) && IN(pb + 2)) { F.refresh(P.ws); phase_prep(F, l, true); } }
        SEAM(pb + 2);
        for (int rp = 0; rp < ((REPEAT_KIND >= 40 && REPEAT_KIND <= 43) ? 2 : RPT(4)); ++rp) if (EN(4) && IN(pb + 3)) { F.refresh(P.ws); phase_mix(F, l, l + 2 * rp, (rp == 1 && REPEAT_KIND >= 40 && REPEAT_KIND <= 43) ? (REPEAT_KIND - 39) : 0); }
        SEAM(pb + 3);
        for (int rp = 0; rp < RPT(5); ++rp) if (EN(5) && IN(pb + 4)) { F.refresh(P.ws); phase_fin(F, l, nr2); }
        SEAM(pb + 4);
        for (int rp = 0; rp < RPT(6); ++rp) if (EN(6) && IN(pb + 5)) { F.refresh(P.ws); pg8::Gemm g{F.outs(), F.wbr(), RX, DM, 4096}; pg8::StaticOrder S; S.init(RX, DM, F.G, F.bid); pg8::EpiMerge E{(const unsigned char*)F.g(), F.mb()};
            pg8::gemm_phase<pg8::EpiMerge, pg8::StaticOrder, true, true>(F.lds, g, S, E, F.tid);
            if constexpr (l == 0) { for (int r2 = 0; r2 < RPT(20); ++r2) { F.refresh(P.ws); ctx_gemm<0>(F, l, cs, modl); } } }
        SEAM(pb + 5);
        for (int rp = 0; rp < ((l == 0) ? RPT(10) : 1); ++rp) if (EN(10) && IN(pb + 6)) { F.refresh(P.ws); pg8::Gemm g{F.mb(), F.wout(), RX, DM, DM}; pg8::StaticOrder S; S.init(RX, DM, F.G, F.bid); pg8::EpiDelta E{F.ys(), modl, 2};
            pg8::gemm_phase<pg8::EpiDelta, pg8::StaticOrder, true, true>(F.lds, g, S, E, F.tid);
            if constexpr (l == 0) { for (int r2 = 0; r2 < RPT(20); ++r2) { F.refresh(P.ws); ctx_gemm<1>(F, l, cs, modl); } } }
        SEAM(pb + 6);
        for (int rp = 0; rp < RPT(11); ++rp) if (EN(11) && IN(pb + 7)) { F.refresh(P.ws); phase_norm(F, l, 1, xs, cs, nr2, F.ys()); phase_cvt_uv(F, l); }
        SEAM(pb + 7);
        for (int rp = 0; rp < RPT(12); ++rp) if (EN(12) && IN(pb + 8)) { F.refresh(P.ws); pg8::Gemm g{F.hn(), F.wq(), RX, DM, DM}; pg8::StaticOrder S; S.init(RX, DM, F.G, F.bid); pg8::EpiBf16P E{(bf16_t*)F.qp(), DM};
            pg8::gemm_phase<pg8::EpiBf16P, pg8::StaticOrder, true, true>(F.lds, g, S, E, F.tid);
            if constexpr (l == 0) { for (int r2 = 0; r2 < RPT(20); ++r2) { F.refresh(P.ws); ctx_gemm<2>(F, l, cs, modl); } } }
        SEAM(pb + 8);
        for (int rp = 0; rp < RPT(13); ++rp) if (EN(13) && IN(pb + 9)) { F.refresh(P.ws); phase_topk(F, l, nr2); }
        SEAM(pb + 9);
        for (int rp = 0; rp < RPT(14); ++rp) if (EN(14) && IN(pb + 10)) { F.refresh(P.ws); phase_peer_slice<0>(F, l, nr2, F.out, F.ctxs(), 8 + l * 32 + 72 * rp); }
        SEAM(pb + 10);
        if (EN(15) && IN(pb + 11)) { F.refresh(P.ws); phase_peer_act(F, l, nr2); }
        SEAM(pb + 11);
        if (RPT(16) == 2) { if (EN(16) && IN(pb + 12)) { F.refresh(P.ws); phase_peer_slice<1>(F, l, nr2, F.qp(), F.qp() + (size_t)RX * DM, 8 + l * 32 + 16 + 72, xs, cs, F.ys()); } }
        if (EN(16) && IN(pb + 12)) { F.refresh(P.ws); phase_peer_slice<1>(F, l, nr2, F.out, F.ctxs(), 8 + l * 32 + 16, xs, cs, F.ys()); }
        SEAM(pb + 12);
    };
    layer(std::integral_constant<int, 0>{});
    layer(std::integral_constant<int, 1>{});
#undef IN
#undef SEAM
}

extern "C" void kernel_launch(void* const* d_in, const int* in_sizes, int n_in, void* d_out, int out_size, void* d_ws, size_t ws_size, hipStream_t stream) {
    static int grid = 0;
    if (grid == 0) {
        int dev = 0, cus = 0, per_cu = 0;
        if (hipGetDevice(&dev) != hipSuccess || hipDeviceGetAttribute(&cus, hipDeviceAttributeMultiprocessorCount, dev) != hipSuccess) { fprintf(stderr, "kernel_launch: device query failed\n"); grid = -1; return; }
        if (hipFuncSetAttribute((const void*)mega, hipFuncAttributeMaxDynamicSharedMemorySize, LDS_BYTES) != hipSuccess) { fprintf(stderr, "kernel_launch: hipFuncSetAttribute failed\n"); grid = -1; return; }
        if (hipOccupancyMaxActiveBlocksPerMultiprocessor(&per_cu, (const void*)mega, 512, LDS_BYTES) != hipSuccess || per_cu < 1) fprintf(stderr, "kernel_launch: occupancy query says %d\n", per_cu);
        (void)hipGetLastError();
        grid = cus;
        if (n_in != 31 || out_size != RX * DM || ws_size < WS_END) { fprintf(stderr, "kernel_launch: unexpected shapes (n_in %d out %d ws %zu need %zu)\n", n_in, out_size, ws_size, (size_t)WS_END); grid = -1; return; }
    }
    if (grid < 0) return;
    if (hipMemsetAsync((char*)d_ws + WS_CTL, 0, CTL_BYTES, stream) != hipSuccess) { fprintf(stderr, "kernel_launch: memset failed\n"); return; }
    Params p{};
    for (int i = 0; i < 31; ++i) p.in[i] = (const float*)d_in[i];
    p.out = (float*)d_out; p.ws = (unsigned char*)d_ws;
#if MK_MULTI
    for (int ph = 0; ph < NPH; ++ph) { p.ph_lo = ph; p.ph_hi = ph + 1; hipLaunchKernelGGL(mega, dim3(grid), dim3(512), LDS_BYTES, stream, p);
#ifdef DBG_NAIVE
        if (ph == 1 + 3 || ph == 1 + NPH_L + 3) { const int l = (ph - 1) / NPH_L; hipLaunchKernelGGL(ssd_naive, dim3(32), dim3(256), 0, stream, p, l); hipLaunchKernelGGL(gla_naive, dim3(32), dim3(256), 0, stream, p, l); }
#endif
    }
#else
    p.ph_lo = 0; p.ph_hi = NPH; hipLaunchKernelGGL(mega, dim3(grid), dim3(512), LDS_BYTES, stream, p);
#endif
    const hipError_t le = hipPeekAtLastError();
    if (le != hipSuccess) fprintf(stderr, "kernel_launch: launch failed: %s\n", hipGetErrorName(le));
}
```
